# Optimizing an MI355X kernel written in HIP

```python
import math
import jax, jax.numpy as jnp
from jax import lax
import numpy as np

D_MODEL = 2048
BATCH = 1
SEQ = 8192
DEPTH = 1
DEC_BATCH = 32
DEC_SEQ = 4
PAST_LEN = 8192
PAGE_SIZE = 128

RWKV_WIDTH = D_MODEL // 2
RWKV_HEAD_SIZE = 64
RWKV_HEADS = RWKV_WIDTH // RWKV_HEAD_SIZE
DECAY_LORA = 64
AAA_LORA = 64
GATE_LORA = 160
RWKV_GN_EPS = 64e-5
NSA_WIDTH = D_MODEL // 2
HEAD_DIM = 64
NSA_HEADS = NSA_WIDTH // HEAD_DIM
NSA_KV_HEADS = 4
NSA_GROUP = NSA_HEADS // NSA_KV_HEADS
CMP_STRIDE = 16
CMP_BLOCK = 2 * CMP_STRIDE
CMP_RANK = 4
SEL_BLOCK = 64
N_SEL = 16
WINDOW = 512
Q_BLOCK = 128
ATTN_SCALE = HEAD_DIM ** -0.5
FFN_HIDDEN = 256 * math.ceil(8 * D_MODEL / 3 / 256)
DEEPNORM_ALPHA = (2 * DEPTH) ** 0.25
DEEPNORM_BETA = (8 * DEPTH) ** -0.25
LN_EPS = 1e-5
NEG_INF = -1e30
FORCE = 1e9
RWKV_COLS = 3 * RWKV_WIDTH + DECAY_LORA + AAA_LORA + GATE_LORA
Q_COLS = NSA_HEADS * HEAD_DIM
KV_COLS = 3 * 2 * NSA_KV_HEADS * HEAD_DIM
NSA_GATE_COLS = 3 * NSA_HEADS
MERGE_GATE_COLS = 2 * D_MODEL
IN_COLS = RWKV_COLS + Q_COLS + KV_COLS + NSA_GATE_COLS + MERGE_GATE_COLS

kernel_name = 'hybrid_rwkv7_nsa_macaron_deepnorm_step'


def layer_norm(x, g, b):
    xf = x.astype(jnp.float32)
    mu = xf.mean(-1, keepdims=True)
    var = jnp.square(xf - mu).mean(-1, keepdims=True)
    return ((xf - mu) * lax.rsqrt(var + LN_EPS) * g.astype(jnp.float32) + b.astype(jnp.float32)).astype(x.dtype)


def swiglu(x, w_gu, w_down):
    gate, up = jnp.split(x @ w_gu, 2, axis=-1)
    return (jax.nn.silu(gate) * up) @ w_down


def half_ffn_post_norm(x, w_gu, w_down, g, b):
    return layer_norm(DEEPNORM_ALPHA * x + 0.5 * swiglu(x, w_gu, w_down), g, b)


def gated_merge_post_norm(h, ya, yb, gm, w_o, g, b):
    mix = (gm[:, :, 0] * ya + gm[:, :, 1] * yb) @ w_o
    return layer_norm(DEEPNORM_ALPHA * h + mix, g, b)


def split_projection(u):
    bsz, t = u.shape[:2]
    o = 0
    ua = u[..., o:o + RWKV_COLS]; o += RWKV_COLS
    q = u[..., o:o + Q_COLS]; o += Q_COLS
    kv = u[..., o:o + KV_COLS]; o += KV_COLS
    gn = u[..., o:o + NSA_GATE_COLS]; o += NSA_GATE_COLS
    gm = u[..., o:o + MERGE_GATE_COLS]
    q = q.reshape(bsz, t, NSA_KV_HEADS, NSA_GROUP, HEAD_DIM)
    kv = kv.reshape(bsz, t, 3, 2, NSA_KV_HEADS, HEAD_DIM)
    gn = jax.nn.sigmoid(gn.reshape(bsz, t, 3, NSA_KV_HEADS, NSA_GROUP))
    gm = jax.nn.sigmoid(gm.reshape(bsz, t, 2, D_MODEL))
    return ua, q, kv, gn, gm


def rwkv7_time_mix(ua, prev_row, s0, mu, w0, w2, a0, a2, g2, k_k, k_a, r_k, ln_w, ln_b, w_up_a):
    bsz, t, _ = ua.shape
    f32 = jnp.float32
    uf = ua.astype(f32)
    prev = jnp.concatenate([prev_row.astype(f32)[:, None], uf[:, :-1]], axis=1)
    um = uf + (prev - uf) * mu.astype(f32)
    W = RWKV_WIDTH
    r, k, v = um[..., :W], um[..., W:2 * W], um[..., 2 * W:3 * W]
    o = 3 * W
    dw = um[..., o:o + DECAY_LORA]; o += DECAY_LORA
    da = um[..., o:o + AAA_LORA]; o += AAA_LORA
    dg = um[..., o:o + GATE_LORA]
    w_log = -jax.nn.softplus(-(w0.astype(f32) + jnp.tanh(dw) @ w2.astype(f32))) - 0.5
    decay = jnp.exp(-jnp.exp(w_log))
    a = jax.nn.sigmoid(a0.astype(f32) + da @ a2.astype(f32))
    g = jax.nn.sigmoid(dg) @ g2.astype(f32)
    H, N = RWKV_HEADS, RWKV_HEAD_SIZE
    heads = lambda z: z.reshape(bsz, t, H, N)
    r, k, v, decay, a = heads(r), heads(k), heads(v), heads(decay), heads(a)
    kk = k * k_k.astype(f32).reshape(H, N)
    kk = kk / jnp.maximum(jnp.sqrt(jnp.sum(kk * kk, -1, keepdims=True)), 1e-12)
    k = k * (1.0 + (a - 1.0) * k_a.astype(f32).reshape(H, N))

    def step(S, inp):
        r_t, w_t, k_t, v_t, kk_t, a_t = inp
        sa = jnp.einsum('bhvk,bhk->bhv', S, kk_t)
        S = (S * w_t[:, :, None, :] - sa[..., None] * (kk_t * a_t)[:, :, None, :]
             + v_t[..., None] * k_t[:, :, None, :])
        return S, jnp.einsum('bhvk,bhk->bhv', S, r_t)

    tm = lambda z: jnp.moveaxis(z, 1, 0)
    s_final, y = lax.scan(step, s0.astype(f32), (tm(r), tm(decay), tm(k), tm(v), tm(kk), tm(a)))
    y = jnp.moveaxis(y, 0, 1)
    ym = y.mean(-1, keepdims=True)
    yv = jnp.square(y - ym).mean(-1, keepdims=True)
    y = ((y - ym) * lax.rsqrt(yv + RWKV_GN_EPS)).reshape(bsz, t, W) * ln_w.astype(f32) + ln_b.astype(f32)
    bonus = (jnp.sum(r * k * r_k.astype(f32), -1, keepdims=True) * v).reshape(bsz, t, W)
    out = ((y + bonus) * g).astype(ua.dtype) @ w_up_a
    return out, s_final, ua[:, -1]


def compress_blocks(rows, cmp_pe, cmp_wa, cmp_wb):
    bsz, t = rows.shape[:2]
    n_ch = t // CMP_STRIDE
    ch = rows[:, :n_ch * CMP_STRIDE].reshape(bsz, n_ch, CMP_STRIDE, 2, NSA_KV_HEADS, HEAD_DIM)
    first = jnp.einsum('bnlshd,slr->bnrshd', ch, cmp_wa[:, :CMP_STRIDE])
    second = jnp.einsum('bnlshd,slr->bnrshd', ch, cmp_wa[:, CMP_STRIDE:])
    pe = jnp.einsum('sld,slr->rsd', cmp_pe, cmp_wa)[:, :, None, :]
    hid = jax.nn.gelu(first[:, :-1] + second[:, 1:] + pe)
    return jnp.einsum('bcrshd,srde->bcshe', hid, cmp_wb)


def nsa_compressed(q, pos, kc, vc):
    nc = kc.shape[1]
    s = jnp.einsum('bqhgd,bchd->bhgqc', q, kc).astype(jnp.float32) * ATTN_SCALE
    blk_end = jnp.arange(nc) * CMP_STRIDE + (CMP_BLOCK - 1)
    valid = blk_end[None, :] <= pos[:, None]
    p = jax.nn.softmax(jnp.where(valid, s, NEG_INF), axis=-1)
    p = jnp.where(valid, p, 0.0)
    return jnp.einsum('bhgqc,bchd->bqhgd', p.astype(vc.dtype), vc), p


def nsa_select(p, pos, n_blocks):
    bsz, kvh, _, tq, nc = p.shape
    ratio = SEL_BLOCK // CMP_STRIDE
    imp = jnp.pad(p.sum(axis=2), ((0, 0), (0, 0), (0, 0), (0, n_blocks * ratio - nc)))
    imp = imp.reshape(bsz, kvh, tq, n_blocks, ratio).sum(-1)
    blk = jnp.arange(n_blocks)
    cur = (pos // SEL_BLOCK)[:, None]
    forced = (blk == 0) | (blk == cur) | (blk == cur - 1)
    future = blk * SEL_BLOCK > pos[:, None]
    score = jnp.where(future, -FORCE, jnp.where(forced, FORCE, imp))
    _, idx = lax.top_k(score, min(N_SEL, n_blocks))
    return idx


def nsa_selected(q, pos, idx, ks, vs):
    s = jnp.einsum('bqhgd,bhqnld->bhgqnl', q, ks).astype(jnp.float32) * ATTN_SCALE
    kpos = idx[..., None] * SEL_BLOCK + jnp.arange(SEL_BLOCK)
    valid = (kpos <= pos[:, None, None])[:, :, None]
    bsz, kvh, g, tq, n, l = s.shape
    p = jax.nn.softmax(jnp.where(valid, s, NEG_INF).reshape(bsz, kvh, g, tq, n * l), axis=-1).reshape(s.shape)
    return jnp.einsum('bhgqnl,bhqnld->bqhgd', p.astype(vs.dtype), vs)


def nsa_window(q, pos, kw, vw, kpos):
    s = jnp.einsum('bqhgd,bkhd->bhgqk', q, kw).astype(jnp.float32) * ATTN_SCALE
    delta = pos[:, None] - kpos[None, :]
    valid = (delta >= 0) & (delta < WINDOW) & (kpos >= 0)[None, :]
    p = jax.nn.softmax(jnp.where(valid, s, NEG_INF), axis=-1)
    return jnp.einsum('bhgqk,bkhd->bqhgd', p.astype(vw.dtype), vw)


def nsa_combine(gn, o_c, o_s, o_w):
    return gn[:, :, 0, ..., None] * o_c + gn[:, :, 1, ..., None] * o_s + gn[:, :, 2, ..., None] * o_w


def nsa_prompt(q, kv, gn, cmp_pe, cmp_wa, cmp_wb):
    bsz, t = q.shape[:2]
    kvc = compress_blocks(kv[:, :, 0], cmp_pe, cmp_wa, cmp_wb)
    kc, vc = kvc[:, :, 0], kvc[:, :, 1]
    n_blocks = -(-t // SEL_BLOCK)
    sel = jnp.pad(kv[:, :, 1], ((0, 0), (0, n_blocks * SEL_BLOCK - t), (0, 0), (0, 0), (0, 0)))
    sel = sel.reshape(bsz, n_blocks, SEL_BLOCK, 2, NSA_KV_HEADS, HEAD_DIM)
    win = jnp.pad(kv[:, :, 2], ((0, 0), (WINDOW, 0), (0, 0), (0, 0), (0, 0)))
    bi = jnp.arange(bsz)[:, None, None, None]
    hi = jnp.arange(NSA_KV_HEADS)[None, :, None, None]
    n_qb = t // Q_BLOCK

    def query_block(args):
        qb, gb, start = args
        pos = start + jnp.arange(Q_BLOCK)
        o_c, p = nsa_compressed(qb, pos, kc, vc)
        idx = nsa_select(p, pos, n_blocks)
        blk = sel[bi, idx, :, :, hi, :]
        o_s = nsa_selected(qb, pos, idx, blk[..., 0, :], blk[..., 1, :])
        span = lax.dynamic_slice_in_dim(win, start, WINDOW + Q_BLOCK, axis=1)
        kpos = start - WINDOW + jnp.arange(WINDOW + Q_BLOCK)
        o_w = nsa_window(qb, pos, span[:, :, 0], span[:, :, 1], kpos)
        return nsa_combine(gb, o_c, o_s, o_w)

    to_blocks = lambda z: jnp.moveaxis(z.reshape(bsz, n_qb, Q_BLOCK, *z.shape[2:]), 1, 0)
    out = lax.map(query_block, (to_blocks(q), to_blocks(gn), jnp.arange(n_qb) * Q_BLOCK))
    return jnp.moveaxis(out, 0, 1).reshape(bsz, t, NSA_WIDTH)


def nsa_sample(q, kv, gn, cache_cmp_kv, cache_sel_kv, page_table, state_win_kv, cmp_pe, cmp_wa, cmp_wb):
    nb, nt = q.shape[:2]
    past = page_table.shape[1] * PAGE_SIZE
    pos = past + jnp.arange(nt)
    past_cmp = cache_cmp_kv[page_table].reshape(nb, past, 2, NSA_KV_HEADS, HEAD_DIM)
    rows_cmp = jnp.concatenate([past_cmp, kv[:, :, 0].astype(past_cmp.dtype)], axis=1)
    kvc = compress_blocks(rows_cmp, cmp_pe, cmp_wa, cmp_wb)
    o_c, p = nsa_compressed(q, pos, kvc[:, :, 0], kvc[:, :, 1])
    n_past_blk = past // SEL_BLOCK
    n_new_blk = -(-nt // SEL_BLOCK)
    idx = nsa_select(p, pos, n_past_blk + n_new_blk)
    bi = jnp.arange(nb)[:, None, None, None]
    hi = jnp.arange(NSA_KV_HEADS)[None, :, None, None]
    sub = PAGE_SIZE // SEL_BLOCK
    pool = cache_sel_kv.reshape(cache_sel_kv.shape[0], sub, SEL_BLOCK, 2, NSA_KV_HEADS, HEAD_DIM)
    ip = jnp.minimum(idx, n_past_blk - 1)
    blk_past = pool[page_table[bi, ip // sub], ip % sub, :, :, hi, :]
    new_rows = jnp.pad(kv[:, :, 1], ((0, 0), (0, n_new_blk * SEL_BLOCK - nt), (0, 0), (0, 0), (0, 0)))
    new_rows = new_rows.reshape(nb, n_new_blk, SEL_BLOCK, 2, NSA_KV_HEADS, HEAD_DIM).astype(pool.dtype)
    blk_new = new_rows[bi, jnp.clip(idx - n_past_blk, 0, n_new_blk - 1), :, :, hi, :]
    blk = jnp.where((idx >= n_past_blk)[..., None, None, None], blk_new, blk_past)
    o_s = nsa_selected(q, pos, idx, blk[..., 0, :], blk[..., 1, :])
    win = jnp.concatenate([state_win_kv, kv[:, :, 2].astype(state_win_kv.dtype)], axis=1)
    wb = state_win_kv.shape[1]
    kpos = past - wb + jnp.arange(wb + nt)
    o_w = nsa_window(q, pos, win[:, :, 0], win[:, :, 1], kpos)
    o = nsa_combine(gn, o_c, o_s, o_w).reshape(nb, nt, NSA_WIDTH)
    return o, win[:, wb + nt - min(WINDOW, wb + nt):]


def setup_inputs(seed: int = 0) -> dict:
    key = jax.random.key(seed)
    ks = iter(jax.random.split(key, 48))
    nrm = lambda shape, scale: scale * jax.random.normal(next(ks), shape, jnp.float32)
    n_pages = PAST_LEN // PAGE_SIZE
    n_used = DEC_BATCH * n_pages
    n_pool = n_used + max(1, n_used // 4)
    win_buf = min(WINDOW, PAST_LEN)
    D, F, W = D_MODEL, FFN_HIDDEN, RWKV_WIDTH
    inp = {}
    inp['x_prompt'] = nrm((BATCH, SEQ, D), 1.0)
    inp['x_sample'] = nrm((DEC_BATCH, DEC_SEQ, D), 1.0)
    inp['cache_cmp_kv'] = nrm((n_pool, PAGE_SIZE, 2, NSA_KV_HEADS, HEAD_DIM), 1.0)
    inp['cache_sel_kv'] = nrm((n_pool, PAGE_SIZE, 2, NSA_KV_HEADS, HEAD_DIM), 1.0)
    inp['page_table'] = jax.random.permutation(next(ks), n_pool)[:n_used].reshape(DEC_BATCH, n_pages).astype(jnp.int32)
    inp['state_win_kv'] = nrm((DEC_BATCH, win_buf, 2, NSA_KV_HEADS, HEAD_DIM), 1.0)
    inp['state_rwkv'] = nrm((DEC_BATCH, RWKV_HEADS, RWKV_HEAD_SIZE, RWKV_HEAD_SIZE), 0.5)
    inp['state_rwkv_shift'] = nrm((DEC_BATCH, RWKV_COLS), 1.0)
    inp['ln1_g'] = 1.0 + nrm((D,), 0.02)
    inp['ln1_b'] = nrm((D,), 0.02)
    inp['ffn1_w_gu'] = nrm((D, 2 * F), D ** -0.5)
    inp['ffn1_w_down'] = nrm((F, D), F ** -0.5 * DEEPNORM_BETA)
    inp['w_in'] = nrm((D, IN_COLS), D ** -0.5)
    inp['rwkv_mu'] = jax.random.uniform(next(ks), (RWKV_COLS,), jnp.float32)
    inp['rwkv_w0'] = jax.random.uniform(next(ks), (W,), jnp.float32, minval=-2.0, maxval=0.0)
    inp['rwkv_w2'] = nrm((DECAY_LORA, W), 0.5 * DECAY_LORA ** -0.5)
    inp['rwkv_a0'] = nrm((W,), 0.5)
    inp['rwkv_a2'] = nrm((AAA_LORA, W), AAA_LORA ** -0.5)
    inp['rwkv_g2'] = nrm((GATE_LORA, W), GATE_LORA ** -0.5)
    inp['rwkv_k_k'] = 0.85 + nrm((W,), 0.05)
    inp['rwkv_k_a'] = 1.0 + nrm((W,), 0.05)
    inp['rwkv_r_k'] = nrm((RWKV_HEADS, RWKV_HEAD_SIZE), 0.1)
    inp['rwkv_ln_w'] = 1.0 + nrm((W,), 0.02)
    inp['rwkv_ln_b'] = nrm((W,), 0.02)
    inp['w_up_a'] = nrm((W, D), W ** -0.5 * DEEPNORM_BETA)
    inp['cmp_pe'] = nrm((2, CMP_BLOCK, HEAD_DIM), 0.1)
    inp['cmp_wa'] = nrm((2, CMP_BLOCK, CMP_RANK), CMP_BLOCK ** -0.5)
    inp['cmp_wb'] = nrm((2, CMP_RANK, HEAD_DIM, HEAD_DIM), (CMP_RANK * HEAD_DIM) ** -0.5)
    inp['w_up_b'] = nrm((NSA_WIDTH, D), NSA_WIDTH ** -0.5 * DEEPNORM_BETA)
    inp['w_o'] = nrm((D, D), D ** -0.5 * DEEPNORM_BETA)
    inp['ln2_g'] = 1.0 + nrm((D,), 0.02)
    inp['ln2_b'] = nrm((D,), 0.02)
    inp['ffn2_w_gu'] = nrm((D, 2 * F), D ** -0.5)
    inp['ffn2_w_down'] = nrm((F, D), F ** -0.5 * DEEPNORM_BETA)
    inp['ln3_g'] = 1.0 + nrm((D,), 0.02)
    inp['ln3_b'] = nrm((D,), 0.02)
    return inp


def reference(x_prompt, x_sample, cache_cmp_kv, cache_sel_kv, page_table, state_win_kv, state_rwkv,
              state_rwkv_shift, ln1_g, ln1_b, ffn1_w_gu, ffn1_w_down, w_in, rwkv_mu, rwkv_w0, rwkv_w2,
              rwkv_a0, rwkv_a2, rwkv_g2, rwkv_k_k, rwkv_k_a, rwkv_r_k, rwkv_ln_w, rwkv_ln_b, w_up_a,
              cmp_pe, cmp_wa, cmp_wb, w_up_b, w_o, ln2_g, ln2_b, ffn2_w_gu, ffn2_w_down, ln3_g, ln3_b):
    rwkv_params = (rwkv_mu, rwkv_w0, rwkv_w2, rwkv_a0, rwkv_a2, rwkv_g2, rwkv_k_k, rwkv_k_a, rwkv_r_k,
                   rwkv_ln_w, rwkv_ln_b, w_up_a)
    bp, tp = x_prompt.shape[:2]
    xp, xs = x_prompt, x_sample
    for _ in range(DEPTH):
        hp = half_ffn_post_norm(xp, ffn1_w_gu, ffn1_w_down, ln1_g, ln1_b)
        ua_p, q_p, kv_p, gn_p, gm_p = split_projection(hp @ w_in)
        ya_p, s_p, shift_p = rwkv7_time_mix(
            ua_p, jnp.zeros((bp, RWKV_COLS), ua_p.dtype),
            jnp.zeros((bp, RWKV_HEADS, RWKV_HEAD_SIZE, RWKV_HEAD_SIZE), jnp.float32), *rwkv_params)
        yb_p = nsa_prompt(q_p, kv_p, gn_p, cmp_pe, cmp_wa, cmp_wb) @ w_up_b
        hp = gated_merge_post_norm(hp, ya_p, yb_p, gm_p, w_o, ln2_g, ln2_b)
        xp = half_ffn_post_norm(hp, ffn2_w_gu, ffn2_w_down, ln3_g, ln3_b)
        hs = half_ffn_post_norm(xs, ffn1_w_gu, ffn1_w_down, ln1_g, ln1_b)
        ua_s, q_s, kv_s, gn_s, gm_s = split_projection(hs @ w_in)
        ya_s, s_s, shift_s = rwkv7_time_mix(ua_s, state_rwkv_shift, state_rwkv, *rwkv_params)
        o_s, win_s = nsa_sample(q_s, kv_s, gn_s, cache_cmp_kv, cache_sel_kv, page_table, state_win_kv,
                                cmp_pe, cmp_wa, cmp_wb)
        yb_s = o_s @ w_up_b
        hs = gated_merge_post_norm(hs, ya_s, yb_s, gm_s, w_o, ln2_g, ln2_b)
        xs = half_ffn_post_norm(hs, ffn2_w_gu, ffn2_w_down, ln3_g, ln3_b)
    cd, sd, wd = cache_cmp_kv.dtype, cache_sel_kv.dtype, state_win_kv.dtype
    rd, hd = state_rwkv.dtype, state_rwkv_shift.dtype
    return (xp, xs,
            kv_p[:, :, 0].astype(cd), kv_p[:, :, 1].astype(sd),
            kv_p[:, tp - min(WINDOW, tp):, 2].astype(wd), s_p.astype(rd), shift_p.astype(hd),
            kv_s[:, :, 0].astype(cd), kv_s[:, :, 1].astype(sd),
            win_s.astype(wd), s_s.astype(rd), shift_s.astype(hd))
```

```cpp
#include <hip/hip_runtime.h>
#include <cstdio>
#include <cstdint>
#define XB_TMO      128
#define XB_XCNT(j)  (256  + 64 * (j))
#define XB_XSUB(j)  (1280 + 64 * (j))
#define XB_XGEN(j)  (2304 + 64 * (j))
#define XB_TOP      3328
#define XB_TOPGEN   3392
#define XCD_BAR_WORDS 3456
#define XB_SPIN_CAP (1u << 18)
#define LAS __attribute__((address_space(3)))

__device__ __forceinline__ unsigned xb_ld(unsigned* p)              { return __hip_atomic_load(p, __ATOMIC_RELAXED, __HIP_MEMORY_SCOPE_AGENT); }
__device__ __forceinline__ unsigned xb_add(unsigned* p, unsigned v) { return __hip_atomic_fetch_add(p, v, __ATOMIC_RELAXED, __HIP_MEMORY_SCOPE_AGENT); }
__device__ __forceinline__ unsigned xb_xcc_id() { return (unsigned)__builtin_amdgcn_s_getreg((3 << 11) | 20) & 0xFu; }
#define XB_SPIN(cond, bar) do { unsigned _sp = 0; while (cond) { __builtin_amdgcn_s_sleep(1); \
    if ((++_sp & 255u) == 0u) { if (xb_ld(&(bar)[XB_TMO])) break; if (_sp > XB_SPIN_CAP) { atomicAdd(&(bar)[XB_TMO], 1u); break; } } } } while (0)

struct XcdBarrier {
    unsigned* bar; unsigned x;
    volatile LAS unsigned* st;
};

__device__ __forceinline__ XcdBarrier xcd_barrier_post(unsigned* bar, volatile LAS unsigned* st) {
    XcdBarrier b; b.bar = bar; b.x = xb_xcc_id(); b.st = st;
    if (threadIdx.x == 0) (void)xb_add(&bar[XB_XCNT(b.x)], 1u);
    return b;
}
__device__ __forceinline__ void xcd_barrier_complete(unsigned* bar, unsigned x, unsigned& nloc, unsigned& nx) {
    const unsigned G = gridDim.x * gridDim.y * gridDim.z;
    unsigned sum, cnt, mine, sp = 0u;
    for (;;) {
        sum = 0u; cnt = 0u; mine = 0u;
#pragma unroll
        for (unsigned j = 0; j < 16; ++j) { const unsigned c = xb_ld(&bar[XB_XCNT(j)]); sum += c; cnt += (c > 0u) ? 1u : 0u; mine = (j == x) ? c : mine; }
        if (sum == G) break;
        __builtin_amdgcn_s_sleep(1);
        if ((++sp & 255u) == 0u) { if (xb_ld(&bar[XB_TMO])) break; if (sp > XB_SPIN_CAP) { atomicAdd(&bar[XB_TMO], 1u); break; } }
    }
    nloc = mine > 0u ? mine : 1u; nx = cnt > 0u ? cnt : 1u;
}

__device__ __forceinline__ void xcd_barrier(const XcdBarrier& b) {
    asm volatile("s_waitcnt vmcnt(0)" ::: "memory");
    __syncthreads();
    if (threadIdx.x == 0) {
        unsigned* bar = b.bar;
        __builtin_amdgcn_s_waitcnt(0);
        unsigned nloc = b.st[0], nx = b.st[1];
        if (nloc == 0u) { xcd_barrier_complete(bar, b.x, nloc, nx); b.st[0] = nloc; b.st[1] = nx; }
        const unsigned old = xb_add(&bar[XB_XSUB(b.x)], 1u);
        const unsigned gen = old / nloc;
        if (old + 1u == (gen + 1u) * nloc) {
            __builtin_amdgcn_fence(__ATOMIC_RELEASE, "agent");
            asm volatile("s_waitcnt vmcnt(0)" ::: "memory");
            const unsigned og = xb_add(&bar[XB_TOP], 1u);
            const unsigned tg = og / nx;
            if (og + 1u == (tg + 1u) * nx) xb_add(&bar[XB_TOPGEN], 1u);
            else XB_SPIN(xb_ld(&bar[XB_TOPGEN]) == tg, bar);
            __builtin_amdgcn_fence(__ATOMIC_ACQUIRE, "agent");
            xb_add(&bar[XB_XGEN(b.x)], 1u);
            asm volatile("s_waitcnt vmcnt(0)" ::: "memory");
        } else {
            XB_SPIN(xb_ld(&bar[XB_XGEN(b.x)]) == gen, bar);
            __builtin_amdgcn_fence(__ATOMIC_ACQUIRE, "agent");
            asm volatile("s_waitcnt vmcnt(0)" ::: "memory");
        }
    }
    __syncthreads();
}

namespace pg8 {
#define PG8_LAS __attribute__((address_space(3)))
typedef unsigned short bf16_t;
typedef short bf16x8 __attribute__((ext_vector_type(8)));
typedef float f32x4 __attribute__((ext_vector_type(4)));
typedef unsigned u32x4 __attribute__((ext_vector_type(4)));
constexpr int BM = 256, BK = 64, HALF = 128, HTB = HALF * BK * 2  , STAGE_BYTES = 8 * HTB, NXCD = 8, WGM = 8;

__host__ __device__ __forceinline__ int lds_byte(int r, int c) { const int st = (r >> 4) * 2 + (c >> 5), rr = r & 15, cc = c & 31, ob = rr * 64 + cc * 2; return st * 1024 + (ob ^ (((ob >> 9) & 1) << 5)); }
__host__ __device__ __forceinline__ void stage_rc(int b, int& R, int& C) { const int st = b / 1024, sb = b % 1024, swz = sb ^ (((sb >> 9) & 1) << 5); R = (st >> 1) * 16 + swz / 64; C = (st & 1) * 32 + (swz % 64) / 2; }
__host__ __device__ __forceinline__ int perm32(int rho) { const int n = rho >> 4, i = rho & 15; return 8 * (i >> 2) + 4 * n + (i & 3); }

struct Unit { int pm, pn, kt0, nkt; };
struct Gemm { const bf16_t* A; const bf16_t* Bt; int M, N, K; };

struct StaticOrder {
    int nM, nN, nwg, G, c;
    __host__ __device__ void init(int M, int N, int G_, int c_) { nM = M / BM; nN = N / BM; nwg = nM * nN; G = G_; c = c_; }
    __host__ __device__ bool next(int i, Unit& u) const {
        const long L = (long)i * G + c; if (L >= nwg) return false;
        int wgid = (int)L; { const int q = nwg / NXCD, r = nwg % NXCD, xcd = wgid % NXCD, off = wgid / NXCD; wgid = (xcd < r ? xcd * (q + 1) : r * (q + 1) + (xcd - r) * q) + off; }
        const int nig = WGM * nN, gid = wgid / nig, fm = gid * WGM, gsz = (nM - fm) < WGM ? (nM - fm) : WGM;
        u.pm = fm + ((wgid % nig) % gsz); u.pn = (wgid % nig) / gsz; u.kt0 = 0; u.nkt = 0; return true;
    }
    __device__ __forceinline__ void a_ready(const Unit&) const {}
    __device__ __forceinline__ void done(const Unit&) const {}
};

__device__ __forceinline__ unsigned cvt_pk_bf16(float lo, float hi) { unsigned r; asm volatile("v_cvt_pk_bf16_f32 %0, %1, %2" : "=v"(r) : "v"(lo), "v"(hi)); return r; }
typedef float f32x2 __attribute__((ext_vector_type(2)));
template <class Epi, class Sched, bool ALIGN_EPI = false, bool SP2 = false>
__device__ __forceinline__ void gemm_phase(PG8_LAS unsigned char* lds, const Gemm g, const Sched& S, const Epi& E) {
    int tid_o = threadIdx.x; asm volatile("" : "+v"(tid_o));
    const int tid = tid_o, wid = __builtin_amdgcn_readfirstlane(tid >> 6), lane = tid & 63, wr = wid >> 2, wc = wid & 3, fr = lane & 15, fq = lane >> 4;
    const int K = g.K, nt = K / BK;
    unsigned voffA[2], voffB[2];
#pragma unroll
    for (int i = 0; i < 2; ++i) { int R, C; stage_rc(tid * 16 + i * 8192, R, C); const int Rb = Epi::PERM ? ((R & ~31) + perm32(R & 31)) : R;
        voffA[i] = (unsigned)(R * K + C) * 2u; voffB[i] = (unsigned)(Rb * K + C) * 2u; }
    const size_t kstep = (size_t)(BK * 2);
    const size_t hstep = (size_t)HALF * K * 2;
    const size_t tstep = 2 * hstep;
    const unsigned ldsw = (unsigned)wid * 1024u;
    const int aoff = lds_byte(wr * 64 + fr, fq * 8), boff = lds_byte(wc * 32 + fr, fq * 8);
#define PG8_SA(b, h) (((b) * 2 + (h)) * HTB)
#define PG8_SB(b, h) ((4 + (b) * 2 + (h)) * HTB)
#define PG8_STAGE(bufoff, gbase, voff) do { _Pragma("unroll") for (int _i = 0; _i < 2; ++_i) \
        __builtin_amdgcn_global_load_lds((const unsigned*)((const char*)(gbase) + (voff)[_i]), (PG8_LAS unsigned*)(lds + (bufoff) + ldsw + _i * 8192), 16, 0, 0); } while (0)
#define PG8_LDA(dst, b, h) do { _Pragma("unroll") for (int m = 0; m < 4; ++m) _Pragma("unroll") for (int k = 0; k < 2; ++k) dst[m][k] = *(const PG8_LAS bf16x8*)(lds + PG8_SA(b, h) + aoff + m * 2048 + k * 1024); } while (0)
#define PG8_LDB(dst, b, h) do { _Pragma("unroll") for (int n = 0; n < 2; ++n) _Pragma("unroll") for (int k = 0; k < 2; ++k) dst[n][k] = *(const PG8_LAS bf16x8*)(lds + PG8_SB(b, h) + boff + n * 2048 + k * 1024); } while (0)
#define PG8_MMA(ai, bj, At, Bt) do { __builtin_amdgcn_s_setprio(1); _Pragma("unroll") for (int m = 0; m < 4; ++m) _Pragma("unroll") for (int n = 0; n < 2; ++n) _Pragma("unroll") for (int k = 0; k < 2; ++k) \
        acc[ai][bj][m][n] = __builtin_amdgcn_mfma_f32_16x16x32_bf16(Bt[n][k], At[m][k], acc[ai][bj][m][n], 0, 0, 0); __builtin_amdgcn_s_setprio(0); } while (0)
#define PG8_WAIT_V(n) asm volatile("s_waitcnt vmcnt(" #n ")" ::: "memory")
#define PG8_WAIT_L(n) asm volatile("s_waitcnt lgkmcnt(" #n ")" ::: "memory")
#define PG8_BAR __builtin_amdgcn_s_barrier()
#define PG8_SCHED __builtin_amdgcn_sched_barrier(0)
    Unit cur, nxt; int ui = 0;
    if (!S.next(0, cur)) return;
    f32x4 acc[2][2][4][2];
#pragma unroll
    for (int a = 0; a < 2; ++a)
#pragma unroll
        for (int b = 0; b < 2; ++b)
#pragma unroll
            for (int m = 0; m < 4; ++m)
#pragma unroll
                for (int n = 0; n < 2; ++n) acc[a][b][m][n] = (f32x4){0.f, 0.f, 0.f, 0.f};
    bf16x8 At[4][2], B0[2][2], B1[2][2];
    const char* cA = (const char*)g.A + (size_t)cur.pm * tstep + (size_t)cur.kt0 * kstep; const char* cB = (const char*)g.Bt + (size_t)cur.pn * tstep + (size_t)cur.kt0 * kstep;
    S.a_ready(cur);
    if constexpr (SP2) {
        PG8_STAGE(PG8_SB(0, 0), cB, voffB); PG8_STAGE(PG8_SB(0, 1), cB + hstep, voffB); PG8_STAGE(PG8_SA(0, 0), cA, voffA); PG8_STAGE(PG8_SA(0, 1), cA + hstep, voffA);
        if (wr == 1) PG8_BAR;
        PG8_WAIT_V(2); PG8_BAR;
        PG8_STAGE(PG8_SB(1, 0), cB + kstep, voffB); PG8_STAGE(PG8_SA(1, 0), cA + kstep, voffA); PG8_STAGE(PG8_SB(1, 1), cB + hstep + kstep, voffB);
        PG8_WAIT_V(6); PG8_BAR;
    } else {
        PG8_STAGE(PG8_SB(0, 0), cB, voffB); PG8_STAGE(PG8_SA(0, 0), cA, voffA); PG8_STAGE(PG8_SB(0, 1), cB + hstep, voffB); PG8_STAGE(PG8_SA(0, 1), cA + hstep, voffA);
        if (wr == 1) PG8_BAR;
        PG8_WAIT_V(4); PG8_BAR;
        PG8_STAGE(PG8_SB(1, 0), cB + kstep, voffB); PG8_STAGE(PG8_SA(1, 0), cA + kstep, voffA); PG8_STAGE(PG8_SB(1, 1), cB + hstep + kstep, voffB);
        PG8_WAIT_V(6); PG8_BAR;
    }
    for (;;) {
        const bool has_next = S.next(ui + 1, nxt);
        const char* nA = has_next ? (const char*)g.A + (size_t)nxt.pm * tstep + (size_t)nxt.kt0 * kstep : cA; const char* nB = has_next ? (const char*)g.Bt + (size_t)nxt.pn * tstep + (size_t)nxt.kt0 * kstep : cB;
        const int ntc = cur.nkt ? cur.nkt : nt;
        for (int t = 0; t < ntc; t += 2) {
            const bool last = (t == ntc - 2);
            const char* a1 = cA + (size_t)(t + 1) * kstep;
            const char* a2 = last ? nA : cA + (size_t)(t + 2) * kstep; const char* b2 = last ? nB : cB + (size_t)(t + 2) * kstep;
            const char* a3 = a2 + kstep; const char* b3 = b2 + kstep;
            if (last && has_next) S.a_ready(nxt);
            if constexpr (SP2) {
            PG8_LDB(B0, 0, 0); PG8_LDB(B1, 0, 1); PG8_SCHED; PG8_LDA(At, 0, 0); PG8_STAGE(PG8_SA(1, 1), a1 + hstep, voffA);
            PG8_WAIT_V(8); PG8_WAIT_L(0); PG8_BAR; PG8_MMA(0, 0, At, B0); PG8_MMA(0, 1, At, B1); PG8_BAR; PG8_SCHED;
            PG8_LDA(At, 0, 1); PG8_STAGE(PG8_SB(0, 0), b2, voffB); PG8_STAGE(PG8_SB(0, 1), b2 + hstep, voffB); PG8_STAGE(PG8_SA(0, 0), a2, voffA);
            PG8_WAIT_V(8); PG8_WAIT_L(0); PG8_BAR; PG8_MMA(1, 0, At, B0); PG8_MMA(1, 1, At, B1); PG8_BAR; PG8_SCHED;
            PG8_LDB(B0, 1, 0); PG8_LDB(B1, 1, 1); PG8_SCHED; PG8_LDA(At, 1, 0); PG8_STAGE(PG8_SA(0, 1), a2 + hstep, voffA);
            PG8_WAIT_V(8); PG8_WAIT_L(0); PG8_BAR; PG8_MMA(0, 0, At, B0); PG8_MMA(0, 1, At, B1); PG8_BAR; PG8_SCHED;
            PG8_LDA(At, 1, 1); PG8_STAGE(PG8_SB(1, 0), b3, voffB); PG8_STAGE(PG8_SB(1, 1), b3 + hstep, voffB); PG8_STAGE(PG8_SA(1, 0), a3, voffA);
            PG8_WAIT_V(8); PG8_WAIT_L(0); PG8_BAR; PG8_MMA(1, 0, At, B0); PG8_MMA(1, 1, At, B1); PG8_BAR; PG8_SCHED;
            } else {
            PG8_LDB(B0, 0, 0); PG8_SCHED; PG8_LDA(At, 0, 0); PG8_STAGE(PG8_SA(1, 1), a1 + hstep, voffA);
            PG8_WAIT_L(8); PG8_BAR; PG8_WAIT_L(0); PG8_MMA(0, 0, At, B0); PG8_BAR; PG8_SCHED;
            PG8_LDB(B1, 0, 1); PG8_STAGE(PG8_SB(0, 0), b2, voffB);
            PG8_BAR; PG8_WAIT_L(0); PG8_MMA(0, 1, At, B1); PG8_BAR;
            PG8_LDA(At, 0, 1); PG8_STAGE(PG8_SA(0, 0), a2, voffA);
            PG8_BAR; PG8_WAIT_L(0); PG8_MMA(1, 0, At, B0); PG8_BAR; PG8_SCHED;
            PG8_STAGE(PG8_SB(0, 1), b2 + hstep, voffB);
            PG8_WAIT_V(6); PG8_BAR; PG8_MMA(1, 1, At, B1); PG8_BAR;
            PG8_LDB(B0, 1, 0); PG8_SCHED; PG8_LDA(At, 1, 0); PG8_STAGE(PG8_SA(0, 1), a2 + hstep, voffA);
            PG8_WAIT_L(8); PG8_BAR; PG8_WAIT_L(0); PG8_MMA(0, 0, At, B0); PG8_BAR; PG8_SCHED;
            PG8_LDB(B1, 1, 1); PG8_STAGE(PG8_SB(1, 0), b3, voffB);
            PG8_BAR; PG8_WAIT_L(0); PG8_MMA(0, 1, At, B1); PG8_BAR;
            PG8_LDA(At, 1, 1); PG8_STAGE(PG8_SA(1, 0), a3, voffA);
            PG8_BAR; PG8_WAIT_L(0); PG8_MMA(1, 0, At, B0); PG8_BAR; PG8_SCHED;
            PG8_STAGE(PG8_SB(1, 1), b3 + hstep, voffB);
            PG8_WAIT_V(6); PG8_BAR; PG8_MMA(1, 1, At, B1); PG8_BAR;
            }
        }
        if constexpr (ALIGN_EPI) { if (wr == 0) PG8_BAR; }
        if constexpr (!Epi::AFTER_DRAIN) { E(acc, cur, wr, wc, fr, fq); S.done(cur); }
        if (!has_next) break;
#pragma unroll
        for (int a = 0; a < 2; ++a)
#pragma unroll
            for (int b = 0; b < 2; ++b)
#pragma unroll
                for (int m = 0; m < 4; ++m)
#pragma unroll
                    for (int n = 0; n < 2; ++n) acc[a][b][m][n] = (f32x4){0.f, 0.f, 0.f, 0.f};
        cur = nxt; cA = nA; cB = nB; ++ui;
        if constexpr (ALIGN_EPI) { if (wr == 1) PG8_BAR; }
    }
    PG8_WAIT_V(0);
    if constexpr (!ALIGN_EPI) { if (wr == 0) PG8_BAR; }
    PG8_BAR;
    if constexpr (Epi::AFTER_DRAIN) { E.fused(acc, cur, wr, wc, fr, fq, lds, wid, lane); S.done(cur); }
#undef PG8_SA
#undef PG8_SB
#undef PG8_STAGE
#undef PG8_LDA
#undef PG8_LDB
#undef PG8_MMA
#undef PG8_WAIT_V
#undef PG8_WAIT_L
#undef PG8_BAR
#undef PG8_SCHED
}
}

#ifndef DUPMASK
#define DUPMASK 0
#endif
#define DUP(k) for (int rep_ = 0; rep_ < 1 + ((DUPMASK >> (k)) & 1); ++rep_)
#ifndef PHMASK
#define PHMASK 0x3fff
#endif
namespace {
typedef unsigned short bf16;
typedef float f32x4 __attribute__((ext_vector_type(4)));
typedef unsigned u32x4 __attribute__((ext_vector_type(4)));
typedef unsigned u32x2 __attribute__((ext_vector_type(2)));
typedef short bf16x8 __attribute__((ext_vector_type(8)));
typedef short bf16x4 __attribute__((ext_vector_type(4)));

constexpr int D = 2048, SEQ = 8192, NS = 128, MT = 8320, MP = 8448;
constexpr int F = 5632;
constexpr int RCOLS = 3360, QOFF = 3360, KVOFF = 4384, GNOFF = 5920, GMOFF = 5968, INC = 10064;
constexpr int UAW = 3584;
constexpr int NIN = 10240;
constexpr int PAST = 8192;
constexpr float ALPHA = 1.189207115002721f;
constexpr float NEG = -3.0e38f;
constexpr float QSCALE = 0.125f * 1.4426950408889634f;
constexpr int NTHR = 512;
constexpr int LDS_RING = 131072;
constexpr int LDS_BYTES = 147456;

struct Params {
    const float *x_p, *x_s, *cache_cmp, *cache_sel; const int* pt; const float *state_win, *state_rwkv, *state_shift;
    const float *ln1_g, *ln1_b, *w_gu1, *w_dn1, *w_in, *mu, *w0, *w2, *a0, *a2, *g2, *k_k, *k_a, *r_k, *rln_w, *rln_b, *w_up_a;
    const float *cmp_pe, *cmp_wa, *cmp_wb, *w_up_b, *w_o, *ln2_g, *ln2_b, *w_gu2, *w_dn2, *ln3_g, *ln3_b;
    float *o_y_p, *o_y_s, *o_cmp_p, *o_sel_p, *o_win_p, *o_state_p, *o_shift_p, *o_cmp_s, *o_sel_s, *o_win_s, *o_state_s, *o_shift_s;
    unsigned* bar;
    bf16 *XAb, *ACTb, *H1b, *H2b, *Qb, *Kc, *Vc, *GMb, *ROb, *Ob, *MIXb;
    bf16 *Vtb, *KCb, *VCtb;
    unsigned* ctl;
    bf16 *Wgu1t, *Wdn1t, *Wint, *Wupat, *Wupbt, *Wot, *Wgu2t, *Wdn2t, *Lw2t, *La2t, *Lg2t;
    float *PRE, *LNST, *UA, *MIXA, *SLAB;
    float *SC, *YS, *C12, *G;
    float *KCVs;
#ifdef NSA_CHECK
    float *KCVp, *Ob2;
#endif
};

__device__ __forceinline__ float sigm(float x) { return 1.f / (1.f + __expf(-x)); }
__device__ __forceinline__ float wave_sum(float v) { for (int o = 32; o >= 1; o >>= 1) v += __shfl_xor(v, o); return v; }
__device__ __forceinline__ float wave_max(float v) { for (int o = 32; o >= 1; o >>= 1) v = fmaxf(v, __shfl_xor(v, o)); return v; }
__device__ __forceinline__ float bf_lo(unsigned w) { return __uint_as_float(w << 16); }
__device__ __forceinline__ float bf_hi(unsigned w) { return __uint_as_float(w & 0xffff0000u); }
using pg8::cvt_pk_bf16;

struct PieceOrder : pg8::StaticOrder {
    int npieces, ppt, pkt;
    __device__ bool next(int i, pg8::Unit& u) const {
        if (i == 0) return pg8::StaticOrder::next(0, u);
        if (i == 1 && c < npieces) { u.pm = 32; u.pn = c / ppt; u.kt0 = (c % ppt) * pkt; u.nkt = pkt; return true; }
        return false;
    }
};
struct EpiSwiglu {
    static constexpr bool PERM = true, AFTER_DRAIN = false;
    bf16* O;
    __device__ __forceinline__ void operator()(const f32x4 (&acc)[2][2][4][2], const pg8::Unit& u, int wr, int wc, int fr, int fq) const {
        const int row0 = u.pm * 256 + wr * 64 + fr, col0 = u.pn * 128 + wc * 32 + 8 * fq;
#pragma unroll
        for (int ai = 0; ai < 2; ++ai)
#pragma unroll
            for (int m = 0; m < 4; ++m) {
                float v[8];
#pragma unroll
                for (int n = 0; n < 2; ++n)
#pragma unroll
                    for (int j = 0; j < 4; ++j) { const float g = acc[ai][0][m][n][j], up = acc[ai][1][m][n][j]; v[n * 4 + j] = g * up * __builtin_amdgcn_rcpf(1.f + __expf(-g)); }
                u32x4 w; w.x = cvt_pk_bf16(v[0], v[1]); w.y = cvt_pk_bf16(v[2], v[3]); w.z = cvt_pk_bf16(v[4], v[5]); w.w = cvt_pk_bf16(v[6], v[7]);
                *(u32x4*)(O + (size_t)(row0 + ai * 128 + m * 16) * F + col0) = w;
            }
    }
};
struct EpiResid {
    static constexpr bool PERM = false, AFTER_DRAIN = false;
    float* O; const float* r0; const float* r1; float s; float* SL; int ppt; const float* st; const float* lg; const float* lb;
    __device__ __forceinline__ void operator()(const f32x4 (&acc)[2][2][4][2], const pg8::Unit& u, int wr, int wc, int fr, int fq) const {
        const int col0 = u.pn * 256 + wc * 32 + 4 * fq;
        if (u.nkt) {
            float* sl = SL + ((size_t)(u.pn * ppt + u.kt0 / u.nkt) * 128 + wr * 64 + fr) * 256 + wc * 32 + 4 * fq;
#pragma unroll
            for (int m = 0; m < 4; ++m)
#pragma unroll
                for (int bj = 0; bj < 2; ++bj)
#pragma unroll
                    for (int n = 0; n < 2; ++n) *(f32x4*)(sl + m * 16 * 256 + bj * 128 + n * 16) = acc[0][bj][m][n] * s;
            return;
        }
#pragma unroll
        for (int ai = 0; ai < 2; ++ai) {
            if (!(u.pm == 32 && ai == 1))
#pragma unroll
            for (int m = 0; m < 4; ++m) {
                const int row = u.pm * 256 + ai * 128 + wr * 64 + m * 16 + fr;
                const float* rp = (u.pm < 32) ? r0 + (size_t)row * D : r1 + (size_t)(row - SEQ) * D;
                float* op = O + (size_t)row * D;
#pragma unroll
                for (int bj = 0; bj < 2; ++bj)
#pragma unroll
                    for (int n = 0; n < 2; ++n) { const int c = col0 + bj * 128 + n * 16;
                        f32x4 rv;
                        if (st) { const float mean = st[2 * row], rstd = st[2 * row + 1]; rv = (*(const f32x4*)(op + c) - mean) * rstd * *(const f32x4*)(lg + c) + *(const f32x4*)(lb + c); }
                        else rv = *(const f32x4*)(rp + c);
                        *(f32x4*)(op + c) = rv * ALPHA + acc[ai][bj][m][n] * s; }
            }
        }
    }
};
struct EpiWin {
    static constexpr bool PERM = true, AFTER_DRAIN = false;
    float* UA; bf16* Qb; bf16* Kc; bf16* Vc; bf16* GMb;
    float *o_cmp_p, *o_sel_p, *o_win_p, *o_shift_p, *o_cmp_s, *o_sel_s, *o_win_s, *o_shift_s;
    __device__ __forceinline__ void operator()(const f32x4 (&acc)[2][2][4][2], const pg8::Unit& u, int wr, int wc, int fr, int fq) const {
#pragma unroll
        for (int ai = 0; ai < 2; ++ai) {
            if (!(u.pm == 32 && ai == 1))
#pragma unroll
            for (int m = 0; m < 4; ++m) {
                const int row = u.pm * 256 + ai * 128 + wr * 64 + m * 16 + fr;
#pragma unroll
                for (int bj = 0; bj < 2; ++bj) {
                    const int v = u.pn * 256 + bj * 128 + wc * 32 + 8 * fq;
                    const f32x4 a0 = acc[ai][bj][m][0], a1 = acc[ai][bj][m][1];
                    if (u.pn < 14) {
                        float* dst = UA + (size_t)row * UAW + v; *(f32x4*)dst = a0; *(f32x4*)(dst + 4) = a1;
                        if (v < RCOLS) {
                            if (row == SEQ - 1) { *(f32x4*)(o_shift_p + v) = a0; *(f32x4*)(o_shift_p + v + 4) = a1; }
                            if (row >= SEQ && ((row - SEQ) & 3) == 3) { float* d2 = o_shift_s + (size_t)((row - SEQ) >> 2) * RCOLS + v; *(f32x4*)d2 = a0; *(f32x4*)(d2 + 4) = a1; }
                        }
                    } else if (u.pn < 18) {
                        u32x4 w; w.x = cvt_pk_bf16(a0[0] * QSCALE, a0[1] * QSCALE); w.y = cvt_pk_bf16(a0[2] * QSCALE, a0[3] * QSCALE); w.z = cvt_pk_bf16(a1[0] * QSCALE, a1[1] * QSCALE); w.w = cvt_pk_bf16(a1[2] * QSCALE, a1[3] * QSCALE);
                        *(u32x4*)(Qb + (size_t)row * 1024 + (v - 3584)) = w;
                    } else if (u.pn < 24) {
                        const int kc = v - 4608, br = kc >> 9, wi = kc & 511;
                        u32x4 w; w.x = cvt_pk_bf16(a0[0], a0[1]); w.y = cvt_pk_bf16(a0[2], a0[3]); w.z = cvt_pk_bf16(a1[0], a1[1]); w.w = cvt_pk_bf16(a1[2], a1[3]);
                        { const int kvh_ = (kc >> 6) & 3, d8 = kc & 63;
                          if ((kc >> 8) & 1) *(u32x4*)(Vc + ((size_t)(br * 4 + kvh_) * MP + row) * 64 + d8) = w;
                          else *(u32x4*)(Kc + (size_t)(br * 4 + kvh_) * MP * 64 + (size_t)(row >> 4) * 1024 + (d8 >> 5) * 512 + ((d8 >> 3) & 3) * 128 + (row & 15) * 8) = w; }
                        float* dst = nullptr;
                        if (row < SEQ) { if (br == 0) dst = o_cmp_p + (size_t)row * 512 + wi; else if (br == 1) dst = o_sel_p + (size_t)row * 512 + wi; else if (row >= SEQ - 512) dst = o_win_p + (size_t)(row - (SEQ - 512)) * 512 + wi; }
                        else { const int s = row - SEQ; if (br == 0) dst = o_cmp_s + (size_t)s * 512 + wi; else if (br == 1) dst = o_sel_s + (size_t)s * 512 + wi; else dst = o_win_s + ((size_t)(s >> 2) * 512 + 508 + (s & 3)) * 512 + wi; }
                        if (dst) { *(f32x4*)dst = a0; *(f32x4*)(dst + 4) = a1; }
                    } else {
                        u32x4 w; w.x = cvt_pk_bf16(sigm(a0[0]), sigm(a0[1])); w.y = cvt_pk_bf16(sigm(a0[2]), sigm(a0[3])); w.z = cvt_pk_bf16(sigm(a1[0]), sigm(a1[1])); w.w = cvt_pk_bf16(sigm(a1[2]), sigm(a1[3]));
                        *(u32x4*)(GMb + (size_t)row * 4096 + (v - 6144)) = w;
                    }
                }
            }
        }
    }
};
template <bool SECOND> struct EpiUp {
    static constexpr bool PERM = true, AFTER_DRAIN = false;
    float* MIXA; bf16* MIXb; const bf16* GM; float* SL; int which;
    __device__ __forceinline__ void operator()(const f32x4 (&acc)[2][2][4][2], const pg8::Unit& u, int wr, int wc, int fr, int fq) const {
        if (u.nkt) {
            float* sl = SL + ((size_t)((which * 8 + u.pn) * 4 + u.kt0 / u.nkt) * 128 + wr * 64 + fr) * 256 + wc * 32 + 8 * fq;
#pragma unroll
            for (int m = 0; m < 4; ++m)
#pragma unroll
                for (int bj = 0; bj < 2; ++bj) {
                    const u32x4 g = *(const u32x4*)(GM + (size_t)(SEQ + wr * 64 + m * 16 + fr) * 4096 + u.pn * 256 + bj * 128 + wc * 32 + 8 * fq);
                    f32x4 a0 = acc[0][bj][m][0], a1 = acc[0][bj][m][1];
                    a0[0] *= bf_lo(g.x); a0[1] *= bf_hi(g.x); a0[2] *= bf_lo(g.y); a0[3] *= bf_hi(g.y);
                    a1[0] *= bf_lo(g.z); a1[1] *= bf_hi(g.z); a1[2] *= bf_lo(g.w); a1[3] *= bf_hi(g.w);
                    *(f32x4*)(sl + m * 16 * 256 + bj * 128) = a0; *(f32x4*)(sl + m * 16 * 256 + bj * 128 + 4) = a1;
                }
            return;
        }
#pragma unroll
        for (int ai = 0; ai < 2; ++ai)
#pragma unroll
            for (int m = 0; m < 4; ++m) {
                const int row = u.pm * 256 + ai * 128 + wr * 64 + m * 16 + fr;
#pragma unroll
                for (int bj = 0; bj < 2; ++bj) {
                    const int c = u.pn * 256 + bj * 128 + wc * 32 + 8 * fq;
                    const u32x4 g = *(const u32x4*)(GM + (size_t)row * 4096 + c);
                    f32x4 a0 = acc[ai][bj][m][0], a1 = acc[ai][bj][m][1];
                    a0[0] *= bf_lo(g.x); a0[1] *= bf_hi(g.x); a0[2] *= bf_lo(g.y); a0[3] *= bf_hi(g.y);
                    a1[0] *= bf_lo(g.z); a1[1] *= bf_hi(g.z); a1[2] *= bf_lo(g.w); a1[3] *= bf_hi(g.w);
                    float* mp = MIXA + (size_t)row * D + c;
                    if (!SECOND) { *(f32x4*)mp = a0; *(f32x4*)(mp + 4) = a1; }
                    else {
                        a0 += *(const f32x4*)mp; a1 += *(const f32x4*)(mp + 4);
                        u32x4 w; w.x = cvt_pk_bf16(a0[0], a0[1]); w.y = cvt_pk_bf16(a0[2], a0[3]); w.z = cvt_pk_bf16(a1[0], a1[1]); w.w = cvt_pk_bf16(a1[2], a1[3]);
                        *(u32x4*)(MIXb + (size_t)row * D + c) = w;
                    }
                }
            }
    }
};

__device__ __forceinline__ int src_col_gu(int n) { const int pn = n >> 8, w = n & 255; return w < 128 ? pn * 128 + w : F + pn * 128 + (w - 128); }
__device__ __forceinline__ int src_col_in(int v) { if (v < 3360) return v; if (v < 3408) return GNOFF + (v - 3360); if (v < 3584) return -1; if (v < 4608) return QOFF + (v - 3584); if (v < 6144) return KVOFF + (v - 4608); return GMOFF + (v - 6144); }
template <int MAP>
__device__ __forceinline__ void transpose_w(const float* __restrict__ W, int K, int ldw, bf16* __restrict__ Wt, int NP, LAS float* scr, int tid, int wg, int nwg) {
    const int ntk = K >> 6, nitems = (NP >> 6) * ntk;
    for (int item = wg; item < nitems; item += nwg) {
        const int n0 = (item / ntk) << 6, k0 = (item % ntk) << 6;
        { const int k = tid >> 3, nc = (tid & 7) * 8, nn = n0 + nc;
          const int sc = MAP == 0 ? nn : (MAP == 1 ? src_col_gu(nn) : (MAP == 3 ? src_col_gu(nn + F) : src_col_in(nn)));
          float4 a = make_float4(0.f, 0.f, 0.f, 0.f), b = a;
          if (sc >= 0) { const float* s = W + (size_t)(k0 + k) * ldw + sc; a = *(const float4*)s; b = *(const float4*)(s + 4); }
          LAS float* d = scr + k * 65 + nc;
          d[0] = a.x; d[1] = a.y; d[2] = a.z; d[3] = a.w; d[4] = b.x; d[5] = b.y; d[6] = b.z; d[7] = b.w; }
        __syncthreads();
        { const int n = tid >> 3, kc = (tid & 7) * 8; const LAS float* s = scr + kc * 65 + n;
          u32x4 w; w.x = cvt_pk_bf16(s[0], s[65]); w.y = cvt_pk_bf16(s[130], s[195]); w.z = cvt_pk_bf16(s[260], s[325]); w.w = cvt_pk_bf16(s[390], s[455]);
          *(u32x4*)(Wt + (size_t)(n0 + n) * K + k0 + kc) = w; }
        __syncthreads();
    }
}

template <bool FINAL>
__device__ __forceinline__ void ln_rows(float* PRE, const float* __restrict__ g, const float* __restrict__ b, float* Hf, bf16* Hb, float* outp, float* outs, const float* SL, int ppt, int gw, int nw, int lane, int wid, LAS float* red) {
    if (blockIdx.x < NS) {
        const int sr = (int)blockIdx.x, row = SEQ + sr, c = wid * 256 + lane * 4;
        f32x4 v = *(const f32x4*)(PRE + (size_t)row * D + c);
        for (int pc = 0; pc < ppt; ++pc) v += *(const f32x4*)(SL + ((size_t)(wid * ppt + pc) * 128 + sr) * 256 + lane * 4);
        const float s = wave_sum((v[0] + v[1]) + (v[2] + v[3]));
        if (lane == 0) red[wid] = s;
        __syncthreads();
        const float mean = ((red[0] + red[1]) + (red[2] + red[3]) + (red[4] + red[5]) + (red[6] + red[7])) * (1.f / D);
        v -= mean;
        const float q = wave_sum((v[0] * v[0] + v[1] * v[1]) + (v[2] * v[2] + v[3] * v[3]));
        if (lane == 0) red[8 + wid] = q;
        __syncthreads();
        const float rs = rsqrtf(((red[8] + red[9]) + (red[10] + red[11]) + (red[12] + red[13]) + (red[14] + red[15])) * (1.f / D) + 1e-5f);
        const f32x4 o = v * rs * *(const f32x4*)(g + c) + *(const f32x4*)(b + c);
        if (FINAL) *(f32x4*)(outs + (size_t)sr * D + c) = o;
        else { *(f32x4*)(PRE + (size_t)row * D + c) = o * ALPHA;
               u32x2 w; w.x = cvt_pk_bf16(o[0], o[1]); w.y = cvt_pk_bf16(o[2], o[3]); *(u32x2*)(Hb + (size_t)row * D + c) = w; }
    }
    for (int row = gw; row < SEQ; row += nw) {
        const float* x = PRE + (size_t)row * D;
        f32x4 v[8]; float s = 0.f;
#pragma unroll
        for (int i = 0; i < 8; ++i) v[i] = *(const f32x4*)(x + (i * 64 + lane) * 4);
#pragma unroll
        for (int i = 0; i < 8; ++i) s += (v[i][0] + v[i][1]) + (v[i][2] + v[i][3]);
        const float mean = wave_sum(s) * (1.f / D);
        float q = 0.f;
#pragma unroll
        for (int i = 0; i < 8; ++i) { v[i] -= mean; q += (v[i][0] * v[i][0] + v[i][1] * v[i][1]) + (v[i][2] * v[i][2] + v[i][3] * v[i][3]); }
        const float rs = rsqrtf(wave_sum(q) * (1.f / D) + 1e-5f);
        if (!FINAL && lane == 0) { Hf[2 * row] = mean; Hf[2 * row + 1] = rs; }
#pragma unroll
        for (int i = 0; i < 8; ++i) {
            const int c = (i * 64 + lane) * 4;
            const f32x4 o = v[i] * rs * *(const f32x4*)(g + c) + *(const f32x4*)(b + c);
            if (FINAL) *(f32x4*)(outp + (size_t)row * D + c) = o;
            else { u32x2 w; w.x = cvt_pk_bf16(o[0], o[1]); w.y = cvt_pk_bf16(o[2], o[3]); *(u32x2*)(Hb + (size_t)row * D + c) = w; }
        }
    }
}

constexpr int SCH = 6 * 64, SCR = 16 * SCH;
__device__ __forceinline__ float tshift(const Params& p, int row, int col) {
    const bool samp = row >= SEQ; const int t = samp ? ((row - SEQ) & 3) : row;
    const float x = p.UA[(size_t)row * UAW + col];
    const float pv = (t > 0) ? p.UA[(size_t)(row - 1) * UAW + col] : (samp ? p.state_shift[(size_t)((row - SEQ) >> 2) * RCOLS + col] : 0.f);
    return x + (pv - x) * p.mu[col];
}
__device__ __forceinline__ f32x4 tshift4(const Params& p, int row, int col) {
    const bool samp = row >= SEQ; const int t = samp ? ((row - SEQ) & 3) : row;
    const f32x4 x = *(const f32x4*)(p.UA + (size_t)row * UAW + col);
    f32x4 pv = {0.f, 0.f, 0.f, 0.f};
    if (t > 0) pv = *(const f32x4*)(p.UA + (size_t)(row - 1) * UAW + col);
    else if (samp) pv = *(const f32x4*)(p.state_shift + (size_t)((row - SEQ) >> 2) * RCOLS + col);
    return x + (pv - x) * *(const f32x4*)(p.mu + col);
}
template <int CTRL> __device__ __forceinline__ float dpp_mov(float x) { return __builtin_bit_cast(float, __builtin_amdgcn_update_dpp(0, __builtin_bit_cast(int, x), CTRL, 0xf, 0xf, false)); }
__device__ __forceinline__ float row_sum16(float x) { x += dpp_mov<0x128>(x); x += dpp_mov<0x124>(x); x += dpp_mov<0x122>(x); x += dpp_mov<0x121>(x); return x; }
__device__ __forceinline__ float half_sum32(float x) { x = row_sum16(x); return x + __shfl_xor(x, 16); }
typedef float f32x16p __attribute__((ext_vector_type(16)));
constexpr int PA_LD = 296;
__device__ __forceinline__ void rwkv_prep_phase(const Params& p, LAS unsigned char* ldsb, int tid) {
    LAS bf16* Ai = (LAS bf16*)ldsb;
    const int lane = tid & 63, w = tid >> 6, l31 = lane & 31, kh = lane >> 5;
    LAS float* stS = (LAS float*)(ldsb + 20480) + w * 3072;
    for (int pass = 0; pass < 2; ++pass) {
        if (pass == 1 && blockIdx.x >= 64) break;
        const int tile = pass == 0 ? (int)blockIdx.x : 256 + ((int)blockIdx.x >> 4);
        const int hbeg = pass == 0 ? 2 * w : ((int)blockIdx.x & 15), nhd = pass == 0 ? 2 : (w == 0 ? 1 : 0);
        const int row0 = tile * 32;
#pragma unroll 6
        for (int it = 0; it < 18; ++it) {
            const int e = tid + it * NTHR, r = e / 288, c = e - r * 288;
            const float u = tshift(p, row0 + r, 3072 + c);
            const float th = 1.f - 2.f * __builtin_amdgcn_rcpf(__expf(2.f * u) + 1.f);
            Ai[r * PA_LD + c] = (bf16)(cvt_pk_bf16(c < 64 ? th : (c < 128 ? u : sigm(u)), 0.f) & 0xffffu);
        }
        __syncthreads();
#pragma unroll 1
        for (int hh = 0; hh < nhd; ++hh) {
            const int hd = hbeg + hh;
            f32x16p zw[2], za[2], zg[2];
#pragma unroll
            for (int t = 0; t < 2; ++t) {
                const int ch = hd * 64 + t * 32 + l31;
                const f32x16p iw = {0.f,0.f,0.f,0.f,0.f,0.f,0.f,0.f,0.f,0.f,0.f,0.f,0.f,0.f,0.f,0.f};
                zw[t] = iw; za[t] = iw; zg[t] = iw;
                const LAS bf16* ap = Ai + l31 * PA_LD + 8 * kh;
                const bf16* bw = p.Lw2t + (size_t)ch * 64 + 8 * kh; const bf16* ba = p.La2t + (size_t)ch * 64 + 8 * kh; const bf16* bg = p.Lg2t + (size_t)ch * 160 + 8 * kh;
#pragma unroll
                for (int ks = 0; ks < 4; ++ks) {
                    zw[t] = __builtin_amdgcn_mfma_f32_32x32x16_bf16(*(const LAS bf16x8*)(ap + ks * 16), *(const bf16x8*)(bw + ks * 16), zw[t], 0, 0, 0);
                    za[t] = __builtin_amdgcn_mfma_f32_32x32x16_bf16(*(const LAS bf16x8*)(ap + 64 + ks * 16), *(const bf16x8*)(ba + ks * 16), za[t], 0, 0, 0);
                }
#pragma unroll
                for (int ks = 0; ks < 10; ++ks) zg[t] = __builtin_amdgcn_mfma_f32_32x32x16_bf16(*(const LAS bf16x8*)(ap + 128 + ks * 16), *(const bf16x8*)(bg + ks * 16), zg[t], 0, 0, 0);
            }
            float w0c[2], a0c[2], kkw[2], kaw[2], rkw[2], mur[2], muk[2], muv[2];
#pragma unroll
            for (int t = 0; t < 2; ++t) { const int ch = hd * 64 + t * 32 + l31; w0c[t] = p.w0[ch]; a0c[t] = p.a0[ch]; kkw[t] = p.k_k[ch]; kaw[t] = p.k_a[ch]; rkw[t] = p.r_k[ch];
                mur[t] = p.mu[ch]; muk[t] = p.mu[1024 + ch]; muv[t] = p.mu[2048 + ch]; }
#pragma unroll
            for (int r = 0; r < 16; ++r) {
                int row_ = row0 + (r & 3) + 8 * (r >> 2) + 4 * kh; asm volatile("" : "+v"(row_));
                const int row = row_;
                const bool samp = row >= SEQ; const int tt = samp ? ((row - SEQ) & 3) : row;
                const float* ux = p.UA + (size_t)row * UAW;
                const float* up = (tt > 0) ? ux - UAW : (samp ? p.state_shift + (size_t)((row - SEQ) >> 2) * RCOLS : nullptr);
                float rr[2], kx[2], vx[2], ss = 0.f;
#pragma unroll
                for (int t = 0; t < 2; ++t) { const int ch = hd * 64 + t * 32 + l31;
                    const float xr = ux[ch], xk = ux[1024 + ch], xv = ux[2048 + ch];
                    const float pr = up ? up[ch] : 0.f, pk = up ? up[1024 + ch] : 0.f, pv = up ? up[2048 + ch] : 0.f;
                    rr[t] = xr + (pr - xr) * mur[t]; kx[t] = xk + (pk - xk) * muk[t]; vx[t] = xv + (pv - xv) * muv[t];
                    const float kk = kx[t] * kkw[t]; ss += kk * kk; }
                ss = half_sum32(ss);
                const float inv = 1.f / fmaxf(sqrtf(ss), 1e-12f);
                float c1 = 0.f, c2 = 0.f, bon = 0.f;
#pragma unroll
                for (int t = 0; t < 2; ++t) {
                    const float z = -(zw[t][r] + w0c[t]);
                    const float sp = fmaxf(z, 0.f) + __logf(1.f + __expf(-fabsf(z)));
                    const float dec = __expf(-__expf(-sp - 0.5f));
                    const float av = __builtin_amdgcn_rcpf(1.f + __expf(-(za[t][r] + a0c[t])));
                    const float kk = kx[t] * kkw[t] * inv, kt = kx[t] * (1.f + (av - 1.f) * kaw[t]), bb = kk * av;
                    c1 += bb * rr[t]; c2 += kt * rr[t]; bon += rr[t] * kt * rkw[t];
                    LAS float* q = stS + (((r & 3) + 4 * kh) * 6) * 64 + t * 32 + l31;
                    q[0] = kk; q[64] = dec * rr[t]; q[128] = dec; q[192] = bb; q[256] = kt; q[320] = vx[t];
                    p.G[(size_t)row * 1024 + hd * 64 + t * 32 + l31] = zg[t][r];
                }
                c1 = half_sum32(c1); c2 = half_sum32(c2); bon = half_sum32(bon);
                if (l31 == 0) *(f32x4*)(p.C12 + ((size_t)row * 16 + hd) * 4) = (f32x4){c1, c2, bon, 0.f};
                if ((r & 3) == 3) {
                    const int rbase = row0 + 8 * (r >> 2);
#pragma unroll 2
                    for (int rs = 0; rs < 8; ++rs) {
                        float* dst = p.SC + (size_t)(rbase + rs) * SCR + hd * SCH; const LAS float* src = stS + rs * 384;
                        *(f32x4*)(dst + lane * 4) = *(const LAS f32x4*)(src + lane * 4);
                        if (lane < 32) *(f32x4*)(dst + 256 + lane * 4) = *(const LAS f32x4*)(src + 256 + lane * 4);
                    }
                    __builtin_amdgcn_sched_barrier(0);
                }
            }
        }
        __syncthreads();
    }
}


struct ScanGrp { f32x4 kk, wr, ww, bb, kt; float v; };
__device__ __forceinline__ void scan_load(ScanGrp& x, const float* __restrict__ sc, int g, int r4, int kq, int rowv) {
    const float* q = sc + (size_t)(4 * g + r4) * SCR + 4 * kq;
    x.kk = *(const f32x4*)(q); x.wr = *(const f32x4*)(q + 64); x.ww = *(const f32x4*)(q + 128); x.bb = *(const f32x4*)(q + 192); x.kt = *(const f32x4*)(q + 256);
    x.v = sc[(size_t)(4 * g + (kq & 3)) * SCR + 320 + rowv];
}
__device__ __forceinline__ void scan_stage(const ScanGrp& x, LAS float* stg, float (&vj)[4], int r4, int kq) {
    LAS float* w = stg + r4 * 320 + 4 * kq;
    *(LAS f32x4*)(w) = x.kk; *(LAS f32x4*)(w + 64) = x.wr; *(LAS f32x4*)(w + 128) = x.ww; *(LAS f32x4*)(w + 192) = x.bb; *(LAS f32x4*)(w + 256) = x.kt;
    vj[0] = dpp_mov<0x00>(x.v); vj[1] = dpp_mov<0x55>(x.v); vj[2] = dpp_mov<0xAA>(x.v); vj[3] = dpp_mov<0xFF>(x.v);
}
__device__ __forceinline__ void scan_steps(const float (&vj)[4], LAS float* stg, float& S0, float& S1, float& S2, float& S3, float* __restrict__ ys, int r4, int kq) {
    float sa4[4], py4[4];
    f32x4 K[3], R[3], W[3], B[3], T[3];
#define SCAN_RD(jj) { const LAS float* r = stg + (jj) * 320 + 4 * kq; \
        K[(jj) % 3] = *(const LAS f32x4*)(r); R[(jj) % 3] = *(const LAS f32x4*)(r + 64); W[(jj) % 3] = *(const LAS f32x4*)(r + 128); B[(jj) % 3] = *(const LAS f32x4*)(r + 192); T[(jj) % 3] = *(const LAS f32x4*)(r + 256); }
    SCAN_RD(0) SCAN_RD(1)
#pragma unroll
    for (int j = 0; j < 4; ++j) {
        if (j == 0) SCAN_RD(2)
        if (j == 1) SCAN_RD(3)
        __builtin_amdgcn_sched_barrier(0);
        const f32x4 k4 = K[j % 3], r4v = R[j % 3], w4 = W[j % 3], b4 = B[j % 3], t4 = T[j % 3];
        const f32x4 vk = t4 * vj[j];
        float psa = S0 * k4[0] + S1 * k4[1] + S2 * k4[2] + S3 * k4[3];
        py4[j] = S0 * r4v[0] + S1 * r4v[1] + S2 * r4v[2] + S3 * r4v[3];
        S0 = fmaf(S0, w4[0], vk[0]); S1 = fmaf(S1, w4[1], vk[1]); S2 = fmaf(S2, w4[2], vk[2]); S3 = fmaf(S3, w4[3], vk[3]);
        psa = row_sum16(psa); sa4[j] = psa;
        S0 = fmaf(-psa, b4[0], S0); S1 = fmaf(-psa, b4[1], S1); S2 = fmaf(-psa, b4[2], S2); S3 = fmaf(-psa, b4[3], S3);
    }
#undef SCAN_RD
    const bool hi8 = (kq & 8) != 0, hi4 = (kq & 4) != 0;
    float a = hi8 ? py4[2] : py4[0], b = hi8 ? py4[3] : py4[1];
    const float sa_ = hi8 ? py4[0] : py4[2], sb_ = hi8 ? py4[1] : py4[3];
    a += dpp_mov<0x128>(sa_); b += dpp_mov<0x128>(sb_);
    float c = hi4 ? b : a; const float sc_ = hi4 ? a : b;
    c += dpp_mov<0x141>(sc_);
    c += dpp_mov<0xB1>(c); c += dpp_mov<0x4E>(c);
    const float osa = hi8 ? (hi4 ? sa4[3] : sa4[2]) : (hi4 ? sa4[1] : sa4[0]);
    if ((kq & 3) == 0) { float2 o; o.x = osa; o.y = c; *(float2*)(ys + (size_t)(2 * (kq >> 3) + ((kq >> 2) & 1)) * 2048) = o; }
}
__device__ __forceinline__ void scan_group(const ScanGrp& x, LAS float* stg, float& S0, float& S1, float& S2, float& S3, float* __restrict__ ys, int r4, int kq) {
    float vj[4]; scan_stage(x, stg, vj, r4, kq); scan_steps(vj, stg, S0, S1, S2, S3, ys, r4, kq);
}
template <bool SAMPLE>
__device__ __forceinline__ void rwkv_scan_fast(const Params& p, int item, int lane, LAS float* stg  ) {
    const int h = (item >> 4) & 15, rb = item & 15, b = item >> 8, r4 = lane >> 4, kq = lane & 15, rowv = rb * 4 + r4;
    const int row0 = SAMPLE ? SEQ + b * 4 : 0;
    float S0 = 0.f, S1 = 0.f, S2 = 0.f, S3 = 0.f;
    if (SAMPLE) { const f32x4 s = *(const f32x4*)(p.state_rwkv + ((size_t)(b * 16 + h) * 64 + rowv) * 64 + 4 * kq); S0 = s[0]; S1 = s[1]; S2 = s[2]; S3 = s[3]; }
    const float* sc = p.SC + (size_t)row0 * SCR + (size_t)h * SCH;
    float* ys = p.YS + ((size_t)row0 * 1024 + (size_t)h * 64 + rowv) * 2;
    if (SAMPLE) {
        ScanGrp x; scan_load(x, sc, 0, r4, kq, rowv);
        scan_group(x, stg, S0, S1, S2, S3, ys, r4, kq);
    } else {
        constexpr int G = 6, NG = SEQ / 4, NGM = (NG / G) * G;
        ScanGrp x[G];
#define SCAN_LOAD_ASM(X, gg) { const float* q_ = sc + (size_t)(4 * (gg) + r4) * SCR + 4 * kq; const float* qv_ = sc + (size_t)(4 * (gg) + (kq & 3)) * SCR + 320 + rowv; \
        asm volatile("global_load_dwordx4 %0, %5, off\n\tglobal_load_dwordx4 %1, %5, off offset:256\n\tglobal_load_dwordx4 %2, %5, off offset:512\n\tglobal_load_dwordx4 %3, %5, off offset:768\n\t" \
                     "global_load_dwordx4 %4, %5, off offset:1024" : "=&v"(X.kk), "=&v"(X.wr), "=&v"(X.ww), "=&v"(X.bb), "=&v"(X.kt) : "v"(q_) : "memory"); \
        asm volatile("global_load_dword %0, %1, off" : "=&v"(X.v) : "v"(qv_) : "memory"); }
#define SCAN_WAIT(X, N) asm volatile("s_waitcnt vmcnt(" #N ")" : "+v"(X.kk), "+v"(X.wr), "+v"(X.ww), "+v"(X.bb), "+v"(X.kt), "+v"(X.v) :: "memory")
#pragma unroll
        for (int i = 0; i < G; ++i) SCAN_LOAD_ASM(x[i], i);
        for (int g = 0; g < NGM - G; g += G) {
#pragma unroll
            for (int i = 0; i < G; ++i) {
                SCAN_WAIT(x[i], 36);
                float vj[4]; scan_stage(x[i], stg + (i & 1) * 1280, vj, r4, kq);
                __builtin_amdgcn_sched_barrier(0);
                SCAN_LOAD_ASM(x[i], g + i + G);
                __builtin_amdgcn_sched_barrier(0);
                scan_steps(vj, stg + (i & 1) * 1280, S0, S1, S2, S3, ys + (size_t)(g + i) * 4 * 2048, r4, kq);
            }
        }
#pragma unroll
        for (int i = 0; i < G; ++i) {
            SCAN_WAIT(x[i], 0);
            scan_group(x[i], stg + (i & 1) * 1280, S0, S1, S2, S3, ys + (size_t)(NGM - G + i) * 4 * 2048, r4, kq);
        }
#undef SCAN_LOAD_ASM
#undef SCAN_WAIT
        for (int g = NGM; g < NG; ++g) { ScanGrp y; scan_load(y, sc, g, r4, kq, rowv); scan_group(y, stg, S0, S1, S2, S3, ys + (size_t)g * 4 * 2048, r4, kq); }
    }
    float* so = SAMPLE ? p.o_state_s + (size_t)(b * 16 + h) * 4096 : p.o_state_p + (size_t)h * 4096;
    *(f32x4*)(so + (size_t)rowv * 64 + 4 * kq) = (f32x4){S0, S1, S2, S3};
}

__device__ __forceinline__ void rwkv_post_phase(const Params& p, int tid) {
    const int half = tid >> 8, t8 = tid & 255, c0 = t8 * 4, hd = t8 >> 4, cl = (t8 & 15) * 4;
    for (int base = blockIdx.x * 2; base < MT; base += gridDim.x * 2) {
        const int row = base + half;
        const size_t o = (size_t)row * 1024 + c0;
        const f32x4 ya = *(const f32x4*)(p.YS + o * 2), yb = *(const f32x4*)(p.YS + o * 2 + 4);
        const f32x4 v = *(const f32x4*)(p.SC + (size_t)row * SCR + hd * SCH + 320 + cl), g = *(const f32x4*)(p.G + o);
        const f32x4 cc = *(const f32x4*)(p.C12 + ((size_t)row * 16 + hd) * 4);
        f32x4 y;
        y[0] = ya[1] - ya[0] * cc[0] + v[0] * cc[1]; y[1] = ya[3] - ya[2] * cc[0] + v[1] * cc[1];
        y[2] = yb[1] - yb[0] * cc[0] + v[2] * cc[1]; y[3] = yb[3] - yb[2] * cc[0] + v[3] * cc[1];
        float s = (y[0] + y[1]) + (y[2] + y[3]);
        s += __shfl_xor(s, 1); s += __shfl_xor(s, 2); s += __shfl_xor(s, 4); s += __shfl_xor(s, 8);
        const f32x4 d = y - s * (1.f / 64.f);
        float q = d[0] * d[0] + d[1] * d[1] + d[2] * d[2] + d[3] * d[3];
        q += __shfl_xor(q, 1); q += __shfl_xor(q, 2); q += __shfl_xor(q, 4); q += __shfl_xor(q, 8);
        const float rs = rsqrtf(q * (1.f / 64.f) + 64e-5f);
        const f32x4 lw = *(const f32x4*)(p.rln_w + c0), lb = *(const f32x4*)(p.rln_b + c0);
        const f32x4 out = (d * rs * lw + lb + v * cc[2]) * g;
        u32x2 w; w.x = cvt_pk_bf16(out[0], out[1]); w.y = cvt_pk_bf16(out[2], out[3]);
        *(u32x2*)(p.ROb + o) = w;
    }
}

typedef float f32x16 __attribute__((ext_vector_type(16)));
constexpr int CA_LD = 264;
template <bool SAMPLE>
__device__ __forceinline__ void compress_phase(const Params& p, LAS unsigned char* ldsb, int tid, int wg, int nwg) {
    LAS bf16* Am = (LAS bf16*)ldsb;
    LAS bf16* Bm = Am + 2 * 64 * CA_LD;
    LAS float* waL = (LAS float*)(Bm + 2 * 64 * CA_LD);
    const int i = tid, s = i >> 8, hh = (i >> 6) & 3, d = i & 63, lane = tid & 63, w = tid >> 6;
    for (int e = tid; e < 2 * 4 * 64 * 64; e += NTHR) { const int ee = e & 63, dd = (e >> 6) & 63, r = (e >> 12) & 3, ss = e >> 14; Bm[(ss * 64 + ee) * CA_LD + r * 64 + dd] = (bf16)(cvt_pk_bf16(p.cmp_wb[e], 0.f) & 0xffffu); }
    if (tid < 256) waL[tid] = p.cmp_wa[tid];
    float pe4[4] = {0.f, 0.f, 0.f, 0.f};
    for (int l = 0; l < 32; ++l) { const float x = p.cmp_pe[(s * 32 + l) * 64 + d]; const float4 wv = *(const float4*)(p.cmp_wa + (s * 32 + l) * 4); pe4[0] += x * wv.x; pe4[1] += x * wv.y; pe4[2] += x * wv.z; pe4[3] += x * wv.w; }
    __syncthreads();
    const int nunits = SAMPLE ? 32 * 32 : 32;
    for (int unit = wg; unit < nunits; unit += nwg) {
        const int b = unit >> 5, c0 = (unit & 31) * 16;
        auto rowp = [&](int t) -> const float* {
            if (SAMPLE) { const int page = p.pt[b * 64 + (t >> 7)]; return p.cache_cmp + ((size_t)page * 128 + (t & 127)) * 512 + i; }
            return p.o_cmp_p + (size_t)t * 512 + i; };
        float x[16], Fp[4] = {0.f, 0.f, 0.f, 0.f};
#pragma unroll
        for (int l = 0; l < 16; ++l) x[l] = *rowp(c0 * 16 + l);
        for (int n = 0; n <= 16; ++n) {
            float F[4] = {0.f, 0.f, 0.f, 0.f}, G[4] = {0.f, 0.f, 0.f, 0.f};
#pragma unroll
            for (int l = 0; l < 16; ++l) {
                const f32x4 wf = *(const LAS f32x4*)(waL + (s * 32 + l) * 4), wg = *(const LAS f32x4*)(waL + (s * 32 + 16 + l) * 4);
                F[0] += x[l] * wf[0]; F[1] += x[l] * wf[1]; F[2] += x[l] * wf[2]; F[3] += x[l] * wf[3];
                G[0] += x[l] * wg[0]; G[1] += x[l] * wg[1]; G[2] += x[l] * wg[2]; G[3] += x[l] * wg[3];
            }
            if (n < 16 && c0 + n + 1 < 512) {
#pragma unroll
                for (int l = 0; l < 16; ++l) x[l] = *rowp((c0 + n + 1) * 16 + l);
            }
            if (n > 0) {
#pragma unroll
                for (int r = 0; r < 4; ++r) { const float v = Fp[r] + G[r] + pe4[r]; const float hv = v * __builtin_amdgcn_rcpf(1.f + __expf(-1.5957691216057308f * (v + 0.044715f * v * v * v)));
                    Am[(s * 64 + (n - 1) * 4 + hh) * CA_LD + r * 64 + d] = (bf16)(cvt_pk_bf16(hv, 0.f) & 0xffffu); }
            }
#pragma unroll
            for (int r = 0; r < 4; ++r) Fp[r] = F[r];
        }
        __syncthreads();
        {
            const int ws = w >> 2, mt = (w >> 1) & 1, nt = w & 1, l31 = lane & 31, kh = lane >> 5;
            f32x16 acc;
#pragma unroll
            for (int r = 0; r < 16; ++r) acc[r] = 0.f;
            const LAS bf16* ap = Am + (ws * 64 + mt * 32 + l31) * CA_LD + 8 * kh;
            const LAS bf16* bp = Bm + (ws * 64 + nt * 32 + l31) * CA_LD + 8 * kh;
#pragma unroll
            for (int ks = 0; ks < 16; ++ks) acc = __builtin_amdgcn_mfma_f32_32x32x16_bf16(*(const LAS bf16x8*)(ap + ks * 16), *(const LAS bf16x8*)(bp + ks * 16), acc, 0, 0, 0);
#pragma unroll
            for (int r = 0; r < 16; ++r) {
                const int row = mt * 32 + (r & 3) + 8 * (r >> 2) + 4 * kh, c = c0 + (row >> 2), h2 = row & 3, e = nt * 32 + l31;
                if (c < 511) {
                    if (SAMPLE) p.KCVs[((size_t)b * 511 + c) * 512 + ws * 256 + h2 * 64 + e] = acc[r];
                    else {
#ifdef NSA_CHECK
                        p.KCVp[(size_t)c * 512 + ws * 256 + h2 * 64 + e] = acc[r];
#endif
                        const bf16 ob = (bf16)(cvt_pk_bf16(acc[r], 0.f) & 0xffffu);
                        if (ws == 0) p.KCb[(size_t)h2 * 32768 + (size_t)(c >> 4) * 1024 + (e >> 5) * 512 + ((e >> 3) & 3) * 128 + (c & 15) * 8 + (e & 7)] = ob;
                        else { const int kl = c & 31, ta = kl >> 4, sx = (kl >> 2) & 3, jx = (kl & 3) + 4 * ta;
                               p.VCtb[(size_t)h2 * 32768 + (size_t)(c >> 5) * 2048 + (e >> 4) * 512 + (sx * 16 + (e & 15)) * 8 + jx] = ob; }
                    }
                }
            }
        }
        __syncthreads();
    }
}

__device__ __forceinline__ void dot4f(const float* __restrict__ kr, const LAS float* qs, float* s4) {
    float a0 = 0.f, a1 = 0.f, a2 = 0.f, a3 = 0.f;
#pragma unroll
    for (int d = 0; d < 64; d += 4) {
        const float4 k = *(const float4*)(kr + d);
        a0 += k.x * qs[d] + k.y * qs[d + 1] + k.z * qs[d + 2] + k.w * qs[d + 3];
        a1 += k.x * qs[64 + d] + k.y * qs[64 + d + 1] + k.z * qs[64 + d + 2] + k.w * qs[64 + d + 3];
        a2 += k.x * qs[128 + d] + k.y * qs[128 + d + 1] + k.z * qs[128 + d + 2] + k.w * qs[128 + d + 3];
        a3 += k.x * qs[192 + d] + k.y * qs[192 + d + 1] + k.z * qs[192 + d + 2] + k.w * qs[192 + d + 3];
    }
    s4[0] = a0; s4[1] = a1; s4[2] = a2; s4[3] = a3;
}
__device__ __forceinline__ void dot4h(const bf16* __restrict__ kr, const LAS float* qs, float* s4) {
    float a0 = 0.f, a1 = 0.f, a2 = 0.f, a3 = 0.f;
#pragma unroll
    for (int d = 0; d < 64; d += 8) {
        const u32x4 w = *(const u32x4*)(kr + d);
        const float k[8] = {bf_lo(w.x), bf_hi(w.x), bf_lo(w.y), bf_hi(w.y), bf_lo(w.z), bf_hi(w.z), bf_lo(w.w), bf_hi(w.w)};
#pragma unroll
        for (int j = 0; j < 8; ++j) { a0 += k[j] * qs[d + j]; a1 += k[j] * qs[64 + d + j]; a2 += k[j] * qs[128 + d + j]; a3 += k[j] * qs[192 + d + j]; }
    }
    s4[0] = a0; s4[1] = a1; s4[2] = a2; s4[3] = a3;
}
__device__ __forceinline__ void dot4h_frag(const bf16* __restrict__ kmat, int kp, const LAS float* qs, float* s4) {
    float a0 = 0.f, a1 = 0.f, a2 = 0.f, a3 = 0.f;
#pragma unroll
    for (int d = 0; d < 64; d += 8) {
        const u32x4 w = *(const u32x4*)(kmat + (size_t)(kp >> 4) * 1024 + (d >> 5) * 512 + ((d >> 3) & 3) * 128 + (kp & 15) * 8);
        const float k[8] = {bf_lo(w.x), bf_hi(w.x), bf_lo(w.y), bf_hi(w.y), bf_lo(w.z), bf_hi(w.z), bf_lo(w.w), bf_hi(w.w)};
#pragma unroll
        for (int j = 0; j < 8; ++j) { a0 += k[j] * qs[d + j]; a1 += k[j] * qs[64 + d + j]; a2 += k[j] * qs[128 + d + j]; a3 += k[j] * qs[192 + d + j]; }
    }
    s4[0] = a0; s4[1] = a1; s4[2] = a2; s4[3] = a3;
}
__device__ __forceinline__ void wave_softmax(LAS float* s, int n, int lane) {
    float m = NEG;
    for (int i = lane; i < n; i += 64) m = fmaxf(m, s[i]);
    m = wave_max(m);
    float l = 0.f;
    for (int i = lane; i < n; i += 64) { const float x = s[i]; const float pv = (x <= NEG) ? 0.f : exp2f(x - m); s[i] = pv; l += pv; }
    l = wave_sum(l);
    const float inv = l > 0.f ? 1.f / l : 0.f;
    for (int i = lane; i < n; i += 64) s[i] *= inv;
}
__device__ __forceinline__ float bf_at(const bf16* p) { return __uint_as_float(((unsigned)*p) << 16); }

#ifdef NSA_CHECK
template <bool SAMPLE>
__device__ __forceinline__ void nsa_phase(const Params& p, LAS unsigned char* ldsb, int tid) {
    const int half = tid >> 8, t8 = tid & 255, lane = tid & 63, g = (tid >> 6) & 3;
    LAS float* qs = (LAS float*)(ldsb + half * 20480);
    LAS float* sc = qs + 256;
    LAS float* impv = sc + 4096;
    LAS int* selb = (LAS int*)(impv + 132);
    const int nitems = SAMPLE ? NS * 4 : SEQ * 4;
    const int nblk = SAMPLE ? 129 : 128;
    for (int base = blockIdx.x * 2; base < nitems; base += gridDim.x * 2) {
        const int item = base + half;
        const int kvh = item & 3, qi = item >> 2;
        const int b = SAMPLE ? (qi >> 2) : 0, tq = SAMPLE ? (qi & 3) : qi;
        const int pos = SAMPLE ? PAST + tq : tq;
        const int row = SAMPLE ? SEQ + qi : qi;
        qs[g * 64 + lane] = bf_at(p.Qb + (size_t)row * 1024 + (kvh * 4 + g) * 64 + lane);
        const float* gn = p.UA + (size_t)row * UAW + RCOLS;
        const float g0 = sigm(gn[0 * 16 + kvh * 4 + g]), g1 = sigm(gn[1 * 16 + kvh * 4 + g]), g2 = sigm(gn[2 * 16 + kvh * 4 + g]);
        __syncthreads();
        float oacc = 0.f;
        {
#ifdef NSA_CHECK
            const float* kcv = SAMPLE ? p.KCVs + (size_t)b * 511 * 512 : p.KCVp;
#else
            const float* kcv = p.KCVs + (size_t)b * 511 * 512;
#endif
            for (int c = t8; c < 511; c += 256) {
                float s4[4] = {NEG, NEG, NEG, NEG};
                if (c * 16 + 31 <= pos) dot4f(kcv + (size_t)c * 512 + kvh * 64, qs, s4);
                sc[c] = s4[0]; sc[1024 + c] = s4[1]; sc[2048 + c] = s4[2]; sc[3072 + c] = s4[3];
            }
            __syncthreads();
            wave_softmax(sc + g * 1024, 511, lane);
            __syncthreads();
            float o = 0.f;
            for (int c = 0; c < 511; ++c) { const float pv = sc[g * 1024 + c]; if (pv != 0.f) o += pv * kcv[(size_t)c * 512 + 256 + kvh * 64 + lane]; }
            oacc += g0 * o;
            if (t8 < nblk) {
                float s = 0.f;
                for (int cc = 4 * t8; cc < 4 * t8 + 4; ++cc) if (cc < 511) s += (sc[cc] + sc[1024 + cc]) + (sc[2048 + cc] + sc[3072 + cc]);
                const int cur = pos >> 6;
                const bool forced = (t8 == 0) || (t8 == cur) || (t8 == cur - 1);
                const bool future = t8 * 64 > pos;
                impv[t8] = future ? -1e9f : (forced ? 1e9f : s);
            }
            __syncthreads();
            if (g == 0) {
                float cs0 = lane < nblk ? impv[lane] : NEG, cs1 = (lane + 64) < nblk ? impv[lane + 64] : NEG, cs2 = (lane + 128) < nblk ? impv[lane + 128] : NEG;
                for (int it = 0; it < 16; ++it) {
                    float bs = cs0; int bi = lane;
                    if (cs1 > bs) { bs = cs1; bi = lane + 64; }
                    if (cs2 > bs) { bs = cs2; bi = lane + 128; }
                    for (int off = 32; off >= 1; off >>= 1) {
                        const float os = __shfl_xor(bs, off); const int oi = __shfl_xor(bi, off);
                        if (os > bs || (os == bs && oi < bi)) { bs = os; bi = oi; }
                    }
                    if (lane == 0) selb[it] = bi;
                    if (bi == lane) cs0 = NEG;
                    if (bi == lane + 64) cs1 = NEG;
                    if (bi == lane + 128) cs2 = NEG;
                }
            }
            __syncthreads();
        }
        {
            for (int i = t8; i < 1024; i += 256) {
                const int j = selb[i >> 6], l = i & 63, kp = j * 64 + l;
                float s4[4] = {NEG, NEG, NEG, NEG};
                if (kp <= pos) {
                    if (SAMPLE && j < 128) dot4f(p.cache_sel + ((size_t)p.pt[b * 64 + (j >> 1)] * 128 + (j & 1) * 64 + l) * 512 + kvh * 64, qs, s4);
                    else dot4h_frag(p.Kc + (size_t)(4 + kvh) * MP * 64, (SAMPLE ? SEQ + b * 4 + l : kp), qs, s4);
                }
                sc[i] = s4[0]; sc[1024 + i] = s4[1]; sc[2048 + i] = s4[2]; sc[3072 + i] = s4[3];
            }
            __syncthreads();
            wave_softmax(sc + g * 1024, 1024, lane);
            __syncthreads();
            float o = 0.f;
            for (int i = 0; i < 1024; ++i) {
                const float pv = sc[g * 1024 + i];
                if (pv != 0.f) {
                    const int j = selb[i >> 6], l = i & 63;
                    float vv;
                    if (SAMPLE && j < 128) vv = p.cache_sel[((size_t)p.pt[b * 64 + (j >> 1)] * 128 + (j & 1) * 64 + l) * 512 + 256 + kvh * 64 + lane];
                    else vv = bf_at(p.Vc + ((size_t)(4 + kvh) * MP + (SAMPLE ? SEQ + b * 4 + l : j * 64 + l)) * 64 + lane);
                    o += pv * vv;
                }
            }
            oacc += g1 * o;
            __syncthreads();
        }
        {
            for (int i = t8; i < 512; i += 256) {
                const int kp = pos - 511 + i;
                float s4[4] = {NEG, NEG, NEG, NEG};
                if (kp >= 0) {
                    if (SAMPLE && kp < PAST) dot4f(p.state_win + ((size_t)b * 512 + (kp - (PAST - 512))) * 512 + kvh * 64, qs, s4);
                    else dot4h_frag(p.Kc + (size_t)(8 + kvh) * MP * 64, (SAMPLE ? SEQ + b * 4 + (kp - PAST) : kp), qs, s4);
                }
                sc[i] = s4[0]; sc[1024 + i] = s4[1]; sc[2048 + i] = s4[2]; sc[3072 + i] = s4[3];
            }
            __syncthreads();
            wave_softmax(sc + g * 1024, 512, lane);
            __syncthreads();
            float o = 0.f;
            for (int i = 0; i < 512; ++i) {
                const float pv = sc[g * 1024 + i];
                if (pv != 0.f) {
                    const int kp = pos - 511 + i;
                    float vv;
                    if (SAMPLE && kp < PAST) vv = p.state_win[((size_t)b * 512 + (kp - (PAST - 512))) * 512 + 256 + kvh * 64 + lane];
                    else vv = bf_at(p.Vc + ((size_t)(8 + kvh) * MP + (SAMPLE ? SEQ + b * 4 + (kp - PAST) : kp)) * 64 + lane);
                    o += pv * vv;
                }
            }
            oacc += g2 * o;
        }
#ifdef NSA_CHECK
        if (!SAMPLE) p.Ob2[(size_t)row * 1024 + (kvh * 4 + g) * 64 + lane] = oacc; else
#endif
        p.Ob[(size_t)row * 1024 + (kvh * 4 + g) * 64 + lane] = (bf16)(cvt_pk_bf16(oacc, 0.f) & 0xffffu);
        __syncthreads();
    }
}

#endif
template <class RowF>
__device__ __forceinline__ void samp_scores(int n, RowF rowp, const LAS float* qs, LAS float* sc, int kvh, int tid) {
    for (int i = tid; i < n; i += NTHR) { float s4[4]; dot4f(rowp(i) + kvh * 64, qs, s4); sc[i] = s4[0]; sc[1024 + i] = s4[1]; sc[2048 + i] = s4[2]; sc[3072 + i] = s4[3]; }
}
template <class RowF>
__device__ __forceinline__ void samp_pv(int n, int chunk, RowF rowp, const LAS float* sc, LAS float* part, int kvh, int w, int lane) {
    float a0 = 0.f, a1 = 0.f, a2 = 0.f, a3 = 0.f;
    const int k0 = w * chunk, k1 = (k0 + chunk < n) ? k0 + chunk : n;
    int k = k0;
    for (; k + 8 <= k1; k += 8) {
        float v[8];
#pragma unroll
        for (int j = 0; j < 8; ++j) v[j] = rowp(k + j)[256 + kvh * 64 + lane];
#pragma unroll
        for (int j = 0; j < 8; ++j) { a0 += sc[k + j] * v[j]; a1 += sc[1024 + k + j] * v[j]; a2 += sc[2048 + k + j] * v[j]; a3 += sc[3072 + k + j] * v[j]; }
    }
    for (; k < k1; ++k) { const float v = rowp(k)[256 + kvh * 64 + lane]; a0 += sc[k] * v; a1 += sc[1024 + k] * v; a2 += sc[2048 + k] * v; a3 += sc[3072 + k] * v; }
    part[w * 256 + lane] = a0; part[w * 256 + 64 + lane] = a1; part[w * 256 + 128 + lane] = a2; part[w * 256 + 192 + lane] = a3;
}
__device__ __forceinline__ void nsa_sample_phase(const Params& p, LAS unsigned char* ldsb, int tid, int wg, int nwg) {
    const int lane = tid & 63, w = tid >> 6;
    LAS float* qs = (LAS float*)ldsb;
    LAS float* sc = qs + 256;
    LAS float* impv = sc + 4096;
    LAS int* selb = (LAS int*)(impv + 136);
    LAS float* part = (LAS float*)(selb + 16);
    for (int item = wg; item < NS * 4; item += nwg) {
        const int kvh = item & 3, qi = item >> 2, b = qi >> 2, tq = qi & 3, pos = PAST + tq, row = SEQ + qi;
        float g0 = 0.f, g1 = 0.f, g2 = 0.f, oacc = 0.f;
        if (tid < 256) {
            qs[tid] = bf_at(p.Qb + (size_t)row * 1024 + kvh * 256 + tid);
            const float* gn = p.UA + (size_t)row * UAW + RCOLS + kvh * 4 + (tid >> 6);
            g0 = sigm(gn[0]); g1 = sigm(gn[16]); g2 = sigm(gn[32]);
        }
        __syncthreads();
        {
            const float* kcv = p.KCVs + (size_t)b * 511 * 512;
            auto rowp = [&](int c) { return kcv + (size_t)c * 512; };
            samp_scores(511, rowp, qs, sc, kvh, tid);
            __syncthreads();
            if (w < 4) wave_softmax(sc + w * 1024, 511, lane);
            __syncthreads();
            samp_pv(511, 64, rowp, sc, part, kvh, w, lane);
            if (tid < 129) {
                float s = 0.f;
                for (int cc = 4 * tid; cc < 4 * tid + 4; ++cc) if (cc < 511) s += (sc[cc] + sc[1024 + cc]) + (sc[2048 + cc] + sc[3072 + cc]);
                const bool forced = (tid == 0) || (tid == 128) || (tid == 127);
                impv[tid] = forced ? 1e9f : s;
            }
            __syncthreads();
            if (tid < 256) { float o = 0.f;
#pragma unroll
                for (int ww = 0; ww < 8; ++ww) o += part[ww * 256 + tid];
                oacc += g0 * o; }
            if (w == 0) {
                float cs0 = impv[lane], cs1 = impv[lane + 64], cs2 = (lane + 128) < 129 ? impv[lane + 128] : NEG;
                for (int it = 0; it < 16; ++it) {
                    float bs = cs0; int bi = lane;
                    if (cs1 > bs) { bs = cs1; bi = lane + 64; }
                    if (cs2 > bs) { bs = cs2; bi = lane + 128; }
                    for (int off = 32; off >= 1; off >>= 1) { const float os = __shfl_xor(bs, off); const int oi = __shfl_xor(bi, off); if (os > bs || (os == bs && oi < bi)) { bs = os; bi = oi; } }
                    if (lane == 0) selb[it] = bi;
                    if (bi == lane) cs0 = NEG;
                    if (bi == lane + 64) cs1 = NEG;
                    if (bi == lane + 128) cs2 = NEG;
                }
            }
            __syncthreads();
        }
        {
            auto rowp = [&](int i) { const int j = selb[i >> 6], l = i & 63;
                return (j < 128) ? p.cache_sel + ((size_t)p.pt[b * 64 + (j >> 1)] * 128 + (j & 1) * 64 + l) * 512 : p.o_sel_s + (size_t)(b * 4 + (l & 3)) * 512; };
            samp_scores(1024, rowp, qs, sc, kvh, tid);
            __syncthreads();
            for (int i = tid; i < 1024; i += NTHR) if (selb[i >> 6] == 128 && (i & 63) > tq) { sc[i] = NEG; sc[1024 + i] = NEG; sc[2048 + i] = NEG; sc[3072 + i] = NEG; }
            __syncthreads();
            if (w < 4) wave_softmax(sc + w * 1024, 1024, lane);
            __syncthreads();
            samp_pv(1024, 128, rowp, sc, part, kvh, w, lane);
            __syncthreads();
            if (tid < 256) { float o = 0.f;
#pragma unroll
                for (int ww = 0; ww < 8; ++ww) o += part[ww * 256 + tid];
                oacc += g1 * o; }
            __syncthreads();
        }
        {
            auto rowp = [&](int i) { const int kp = pos - 511 + i;
                return (kp < PAST) ? p.state_win + ((size_t)b * 512 + (kp - (PAST - 512))) * 512 : p.o_win_s + ((size_t)b * 512 + 508 + (kp - PAST)) * 512 + 1024 - 1024; };
            samp_scores(512, rowp, qs, sc, kvh, tid);
            __syncthreads();
            if (w < 4) wave_softmax(sc + w * 1024, 512, lane);
            __syncthreads();
            samp_pv(512, 64, rowp, sc, part, kvh, w, lane);
            __syncthreads();
            if (tid < 256) { float o = 0.f;
#pragma unroll
                for (int ww = 0; ww < 8; ++ww) o += part[ww * 256 + tid];
                oacc += g2 * o;
                p.Ob[(size_t)row * 1024 + kvh * 256 + tid] = (bf16)(cvt_pk_bf16(oacc, 0.f) & 0xffffu); }
            __syncthreads();
        }
    }
}

__device__ __forceinline__ void vtrans_phase(const Params& p, LAS bf16* tile  , int tid, int wg, int nwg) {
    for (int item = wg; item < 2 * 4 * 128; item += nwg) {
        const int blk = item & 127, kvh = (item >> 7) & 3, br = item >> 9;
        { const int r = tid >> 3, d8 = (tid & 7) * 8;
          const u32x4 w = *(const u32x4*)(p.Vc + ((size_t)((br + 1) * 4 + kvh) * MP + blk * 64 + r) * 64 + d8);
          *(LAS u32x4*)(tile + r * 72 + d8) = w; }
        __syncthreads();
        { const int hf = tid >> 8, nt = (tid >> 6) & 3, ln = tid & 63, sx = ln >> 4, dim = nt * 16 + (ln & 15); unsigned short e[8];
#pragma unroll
          for (int j = 0; j < 8; ++j) e[j] = tile[(hf * 32 + (j >> 2) * 16 + 4 * sx + (j & 3)) * 72 + dim];
          u32x4 w; w.x = e[0] | ((unsigned)e[1] << 16); w.y = e[2] | ((unsigned)e[3] << 16); w.z = e[4] | ((unsigned)e[5] << 16); w.w = e[6] | ((unsigned)e[7] << 16);
          *(u32x4*)(p.Vtb + ((size_t)br * 4 + kvh) * 128 * 4096 + (size_t)(blk * 2 + hf) * 2048 + nt * 512 + ln * 8) = w; }
        __syncthreads();
    }
}

constexpr float MNEG = -1.0e30f;
struct AttnState { float m, l; f32x4 O[4]; };
__device__ __forceinline__ void attn_reset(AttnState& a) { a.m = MNEG; a.l = 0.f;
#pragma unroll
    for (int i = 0; i < 4; ++i) a.O[i] = (f32x4){0.f, 0.f, 0.f, 0.f}; }
struct KVFrag { bf16x8 Ka0, Ka1, Kb0, Kb1; bf16x8 V[4]; };
__device__ __forceinline__ void kv_load(KVFrag& f, const bf16* __restrict__ kt, const bf16* __restrict__ vs, int lane) {
    f.Ka0 = *(const bf16x8*)(kt + lane * 8); f.Ka1 = *(const bf16x8*)(kt + 512 + lane * 8);
    f.Kb0 = *(const bf16x8*)(kt + 1024 + lane * 8); f.Kb1 = *(const bf16x8*)(kt + 1536 + lane * 8);
#pragma unroll
    for (int nt = 0; nt < 4; ++nt) f.V[nt] = *(const bf16x8*)(vs + nt * 512 + lane * 8);
}
__device__ __forceinline__ void attn_compute(AttnState& a, const KVFrag& f, const bf16x8 Q0, const bf16x8 Q1, const bool (&ok)[8]) {
    f32x4 Sa = {0.f, 0.f, 0.f, 0.f}, Sb = {0.f, 0.f, 0.f, 0.f};
    Sa = __builtin_amdgcn_mfma_f32_16x16x32_bf16(f.Ka0, Q0, Sa, 0, 0, 0); Sa = __builtin_amdgcn_mfma_f32_16x16x32_bf16(f.Ka1, Q1, Sa, 0, 0, 0);
    Sb = __builtin_amdgcn_mfma_f32_16x16x32_bf16(f.Kb0, Q0, Sb, 0, 0, 0); Sb = __builtin_amdgcn_mfma_f32_16x16x32_bf16(f.Kb1, Q1, Sb, 0, 0, 0);
    float sc[8] = {Sa[0], Sa[1], Sa[2], Sa[3], Sb[0], Sb[1], Sb[2], Sb[3]};
    float mx = MNEG;
#pragma unroll
    for (int i = 0; i < 8; ++i) { sc[i] = ok[i] ? sc[i] : MNEG; mx = fmaxf(mx, sc[i]); }
    if (__any(mx > a.m + 8.f)) {
        mx = fmaxf(mx, __shfl_xor(mx, 16)); mx = fmaxf(mx, __shfl_xor(mx, 32));
        const float mn = fmaxf(a.m, mx), scale = __builtin_amdgcn_exp2f(a.m - mn);
        a.m = mn; a.l *= scale;
#pragma unroll
        for (int nt = 0; nt < 4; ++nt) a.O[nt] *= scale;
    }
    const float mref = a.m;
    float pv[8], ps = 0.f;
#pragma unroll
    for (int i = 0; i < 8; ++i) { pv[i] = ok[i] ? __builtin_amdgcn_exp2f(sc[i] - mref) : 0.f; ps += pv[i]; }
    a.l += ps;
    union { bf16x8 v; unsigned u[4]; } P;
    P.u[0] = cvt_pk_bf16(pv[0], pv[1]); P.u[1] = cvt_pk_bf16(pv[2], pv[3]); P.u[2] = cvt_pk_bf16(pv[4], pv[5]); P.u[3] = cvt_pk_bf16(pv[6], pv[7]);
#pragma unroll
    for (int nt = 0; nt < 4; ++nt) a.O[nt] = __builtin_amdgcn_mfma_f32_16x16x32_bf16(f.V[nt], P.v, a.O[nt], 0, 0, 0);
}
__device__ __forceinline__ void attn_finish(const AttnState& a, float gate, f32x4 (&acc)[4]) {
    float L = a.l; L += __shfl_xor(L, 16); L += __shfl_xor(L, 32);
    const float f = L > 0.f ? gate / L : 0.f;
#pragma unroll
    for (int nt = 0; nt < 4; ++nt) acc[nt] += a.O[nt] * f;
}

__device__ __forceinline__ void nsa_prompt_item(const Params& p, int item, int lane, LAS float* impL  , LAS int* selL  , LAS int* stepL  ) {
    const int kvh = item & 3, t0 = (2047 - (item >> 2)) * 4;
    const int col = lane & 15, s = lane >> 4, q = col >> 2, g = col & 3, tq = t0 + q;
    const bf16* qrow = p.Qb + (size_t)tq * 1024 + (kvh * 4 + g) * 64;
    const bf16x8 Q0 = *(const bf16x8*)(qrow + 8 * s), Q1 = *(const bf16x8*)(qrow + 32 + 8 * s);
    const float* gn = p.UA + (size_t)tq * UAW + RCOLS + kvh * 4 + g;
    const float g0 = sigm(gn[0]), g1 = sigm(gn[16]), g2 = sigm(gn[32]);
    f32x4 acc[4] = {{0.f, 0.f, 0.f, 0.f}, {0.f, 0.f, 0.f, 0.f}, {0.f, 0.f, 0.f, 0.f}, {0.f, 0.f, 0.f, 0.f}};
    AttnState st;
    impL[lane] = 0.f; impL[64 + lane] = 0.f; impL[128 + lane] = 0.f; impL[192 + lane] = 0.f; impL[256 + lane] = 0.f; impL[320 + lane] = 0.f; impL[384 + lane] = 0.f; impL[448 + lane] = 0.f;
    {
        const int ncv = (t0 >= 28) ? ((t0 - 28) >> 4) + 1 : 0, nst = (ncv + 31) >> 5;
        const bf16* kc = p.KCb + (size_t)kvh * 512 * 64;
        const bf16* vc = p.VCtb + (size_t)kvh * 8 * 64 * 64;
        float m1 = MNEG, l1 = 0.f;
        for (int st1 = 0; st1 < nst; ++st1) {
            const int c0 = st1 * 32;
            const bf16* kt = kc + (size_t)c0 * 64;
            const bf16x8 Ka0 = *(const bf16x8*)(kt + lane * 8), Ka1 = *(const bf16x8*)(kt + 512 + lane * 8), Kb0 = *(const bf16x8*)(kt + 1024 + lane * 8), Kb1 = *(const bf16x8*)(kt + 1536 + lane * 8);
            f32x4 Sa = {0.f, 0.f, 0.f, 0.f}, Sb = {0.f, 0.f, 0.f, 0.f};
            Sa = __builtin_amdgcn_mfma_f32_16x16x32_bf16(Ka0, Q0, Sa, 0, 0, 0); Sa = __builtin_amdgcn_mfma_f32_16x16x32_bf16(Ka1, Q1, Sa, 0, 0, 0);
            Sb = __builtin_amdgcn_mfma_f32_16x16x32_bf16(Kb0, Q0, Sb, 0, 0, 0); Sb = __builtin_amdgcn_mfma_f32_16x16x32_bf16(Kb1, Q1, Sb, 0, 0, 0);
            float sc[8] = {Sa[0], Sa[1], Sa[2], Sa[3], Sb[0], Sb[1], Sb[2], Sb[3]};
            float mx = MNEG;
#pragma unroll
            for (int i = 0; i < 8; ++i) { const int c = c0 + (i >> 2) * 16 + 4 * s + (i & 3); sc[i] = (c * 16 + 31 <= tq) ? sc[i] : MNEG; mx = fmaxf(mx, sc[i]); }
            mx = fmaxf(mx, __shfl_xor(mx, 16)); mx = fmaxf(mx, __shfl_xor(mx, 32));
            const float mn = fmaxf(m1, mx);
            float ps = 0.f;
#pragma unroll
            for (int i = 0; i < 8; ++i) ps += (sc[i] > MNEG) ? __builtin_amdgcn_exp2f(sc[i] - mn) : 0.f;
            l1 = l1 * __builtin_amdgcn_exp2f(m1 - mn) + ps; m1 = mn;
        }
        l1 += __shfl_xor(l1, 16); l1 += __shfl_xor(l1, 32);
        const float il = l1 > 0.f ? 1.f / l1 : 0.f;
        attn_reset(st);
        for (int st1 = 0; st1 < nst; ++st1) {
            const int c0 = st1 * 32;
            const bf16* kt = kc + (size_t)c0 * 64;
            const bf16x8 Ka0 = *(const bf16x8*)(kt + lane * 8), Ka1 = *(const bf16x8*)(kt + 512 + lane * 8), Kb0 = *(const bf16x8*)(kt + 1024 + lane * 8), Kb1 = *(const bf16x8*)(kt + 1536 + lane * 8);
            bf16x8 Vf[4];
#pragma unroll
            for (int nt = 0; nt < 4; ++nt) Vf[nt] = *(const bf16x8*)(vc + (size_t)c0 * 64 + nt * 512 + lane * 8);
            f32x4 Sa = {0.f, 0.f, 0.f, 0.f}, Sb = {0.f, 0.f, 0.f, 0.f};
            Sa = __builtin_amdgcn_mfma_f32_16x16x32_bf16(Ka0, Q0, Sa, 0, 0, 0); Sa = __builtin_amdgcn_mfma_f32_16x16x32_bf16(Ka1, Q1, Sa, 0, 0, 0);
            Sb = __builtin_amdgcn_mfma_f32_16x16x32_bf16(Kb0, Q0, Sb, 0, 0, 0); Sb = __builtin_amdgcn_mfma_f32_16x16x32_bf16(Kb1, Q1, Sb, 0, 0, 0);
            const float sc[8] = {Sa[0], Sa[1], Sa[2], Sa[3], Sb[0], Sb[1], Sb[2], Sb[3]};
            float pv[8];
#pragma unroll
            for (int i = 0; i < 8; ++i) { const int c = c0 + (i >> 2) * 16 + 4 * s + (i & 3); pv[i] = (c * 16 + 31 <= tq) ? __builtin_amdgcn_exp2f(sc[i] - m1) * il : 0.f; }
            float ia = (pv[0] + pv[1]) + (pv[2] + pv[3]), ib = (pv[4] + pv[5]) + (pv[6] + pv[7]);
            ia += __shfl_xor(ia, 1); ia += __shfl_xor(ia, 2); ib += __shfl_xor(ib, 1); ib += __shfl_xor(ib, 2);
            if (g == 0) { impL[q * 128 + (c0 >> 2) + s] = ia; impL[q * 128 + (c0 >> 2) + 4 + s] = ib; }
            union { bf16x8 v; unsigned u[4]; } P;
            P.u[0] = cvt_pk_bf16(pv[0], pv[1]); P.u[1] = cvt_pk_bf16(pv[2], pv[3]); P.u[2] = cvt_pk_bf16(pv[4], pv[5]); P.u[3] = cvt_pk_bf16(pv[6], pv[7]);
#pragma unroll
            for (int nt = 0; nt < 4; ++nt) st.O[nt] = __builtin_amdgcn_mfma_f32_16x16x32_bf16(Vf[nt], P.v, st.O[nt], 0, 0, 0);
        }
#pragma unroll
        for (int nt = 0; nt < 4; ++nt) acc[nt] += st.O[nt] * g0;
    }
    asm volatile("s_waitcnt lgkmcnt(0)" ::: "memory");
    {
        const int qq = lane >> 4, li = lane & 15, tqq = t0 + qq, cur = tqq >> 6;
        float cs[8];
#pragma unroll
        for (int r = 0; r < 8; ++r) { const int j = li + 16 * r; const bool forced = (j == 0) || (j == cur) || (j == cur - 1); cs[r] = (j * 64 > tqq) ? -1e9f : (forced ? 1e9f : impL[qq * 128 + j]); }
        for (int it = 0; it < 16; ++it) {
            float bs = cs[0]; int bi = li;
#pragma unroll
            for (int r = 1; r < 8; ++r) if (cs[r] > bs) { bs = cs[r]; bi = li + 16 * r; }
#pragma unroll
            for (int off = 8; off >= 1; off >>= 1) { const float os = __shfl_xor(bs, off); const int oi = __shfl_xor(bi, off); if (os > bs || (os == bs && oi < bi)) { bs = os; bi = oi; } }
            if (li == 0) selL[qq * 16 + it] = bi;
#pragma unroll
            for (int r = 0; r < 8; ++r) if (bi == li + 16 * r) cs[r] = NEG;
        }
    }
    asm volatile("s_waitcnt lgkmcnt(0)" ::: "memory");
    {
        const bf16* kbase = p.Kc + (size_t)(4 + kvh) * MP * 64;
        const bf16* vbase = p.Vtb + (size_t)(0 * 4 + kvh) * 128 * 4096;
        int nstep;
        {
            const int cur = t0 >> 6, nf = 1 + (cur > 1 ? 1 : 0) + (cur > 0 ? 1 : 0);
            if (lane < nf) { const int jf = (lane == 0) ? 0 : ((lane == 1 && cur > 1) ? cur - 1 : cur); stepL[2 * lane] = (jf * 64) | (4 << 16); stepL[2 * lane + 1] = (jf * 64 + 32) | (4 << 16); }
            const int qs = lane >> 4, j = selL[lane]; const bool valid = (j * 64 <= t0 + qs) && !(j == 0 || j == cur || j == cur - 1);
            const unsigned long long mask = __ballot(valid);
            const int posn = nf + __popcll(mask & ((1ull << lane) - 1ull));
            if (valid) { stepL[2 * posn] = (j * 64) | (qs << 16); stepL[2 * posn + 1] = (j * 64 + 32) | (qs << 16); }
            nstep = 2 * (nf + __popcll(mask)); }
        asm volatile("s_waitcnt lgkmcnt(0)" ::: "memory");
        attn_reset(st);
        KVFrag F0, F1, F2;
#define SEL_LOAD(F, e_) { const int k0_ = (e_) & 0xffff; kv_load(F, kbase + (size_t)k0_ * 64, vbase + (size_t)k0_ * 64, lane); }
#define SEL_COMP(F, e_) { const int k0_ = (e_) & 0xffff, qs_ = (e_) >> 16; const int lim_ = (qs_ == 4 || q == qs_) ? tq - k0_ - 4 * s : -1; bool ok[8]; \
            _Pragma("unroll") for (int i2 = 0; i2 < 8; ++i2) ok[i2] = ((i2 >> 2) * 16 + (i2 & 3) <= lim_); attn_compute(st, F, Q0, Q1, ok); }
        if (nstep > 0) {
            const int last = nstep - 1;
            int e0 = __builtin_amdgcn_readfirstlane(stepL[0]), e1 = __builtin_amdgcn_readfirstlane(stepL[1 < nstep ? 1 : last]), e2 = __builtin_amdgcn_readfirstlane(stepL[2 < nstep ? 2 : last]);
            SEL_LOAD(F0, e0); SEL_LOAD(F1, e1); SEL_LOAD(F2, e2);
            __builtin_amdgcn_sched_barrier(0);
            for (int i = 0; i < nstep; i += 3) {
                int ev = stepL[i + 3 < nstep ? i + 3 : last];
                SEL_COMP(F0, e0);
                e0 = __builtin_amdgcn_readfirstlane(ev); SEL_LOAD(F0, e0);
                __builtin_amdgcn_sched_barrier(0);
                ev = stepL[i + 4 < nstep ? i + 4 : last];
                if (i + 1 < nstep) SEL_COMP(F1, e1);
                e1 = __builtin_amdgcn_readfirstlane(ev); SEL_LOAD(F1, e1);
                __builtin_amdgcn_sched_barrier(0);
                ev = stepL[i + 5 < nstep ? i + 5 : last];
                if (i + 2 < nstep) SEL_COMP(F2, e2);
                e2 = __builtin_amdgcn_readfirstlane(ev); SEL_LOAD(F2, e2);
                __builtin_amdgcn_sched_barrier(0);
            }
        }
#undef SEL_LOAD
#undef SEL_COMP
        attn_finish(st, g1, acc);
    }
    {
        const bf16* kbase = p.Kc + (size_t)(8 + kvh) * MP * 64;
        const bf16* vbase = p.Vtb + (size_t)(1 * 4 + kvh) * 128 * 4096;
        attn_reset(st);
        const int lo = (t0 >= 511 ? t0 - 511 : 0) & ~31, nst = ((t0 + 3 - lo) >> 5) + 1;
        KVFrag F0, F1;
#define WIN_LOAD(F, i) { const int k0_ = lo + 32 * (i); kv_load(F, kbase + (size_t)k0_ * 64, vbase + (size_t)k0_ * 64, lane); }
#define WIN_COMP(F, i) { const int k0_ = lo + 32 * (i); bool ok[8]; \
            _Pragma("unroll") for (int ii = 0; ii < 8; ++ii) { const int kp = k0_ + (ii >> 2) * 16 + 4 * s + (ii & 3); ok[ii] = (kp <= tq) && (kp > tq - 512); } attn_compute(st, F, Q0, Q1, ok); }
        WIN_LOAD(F0, 0);
        __builtin_amdgcn_sched_barrier(0);
        for (int i = 0; i < nst; i += 2) {
            WIN_LOAD(F1, (i + 1 < nst ? i + 1 : i));
            __builtin_amdgcn_sched_barrier(0);
            WIN_COMP(F0, i);
            WIN_LOAD(F0, (i + 2 < nst ? i + 2 : i));
            __builtin_amdgcn_sched_barrier(0);
            if (i + 1 < nst) WIN_COMP(F1, i + 1);
        }
#undef WIN_LOAD
#undef WIN_COMP
        attn_finish(st, g2, acc);
    }
    bf16* orow = p.Ob + (size_t)tq * 1024 + (kvh * 4 + g) * 64 + 4 * s;
#pragma unroll
    for (int nt = 0; nt < 4; ++nt) { u32x2 w; w.x = cvt_pk_bf16(acc[nt][0], acc[nt][1]); w.y = cvt_pk_bf16(acc[nt][2], acc[nt][3]); *(u32x2*)(orow + nt * 16) = w; }
}

__global__ void __launch_bounds__(NTHR, 2) mega_fwd(Params p) {
    extern __shared__ __attribute__((aligned(16))) unsigned char shm[];
    LAS unsigned char* lds = (LAS unsigned char*)shm;
#define PHASE_IDS int tid = threadIdx.x; asm volatile("" : "+v"(tid)); const int lane = tid & 63, wid = tid >> 6, gw = blockIdx.x * 8 + wid, nw = gridDim.x * 8; (void)lane; (void)gw; (void)nw; \
    const size_t gtid = (size_t)blockIdx.x * NTHR + tid, gthreads = (size_t)gridDim.x * NTHR; (void)gtid; (void)gthreads;
    volatile LAS unsigned* xbw = (volatile LAS unsigned*)(lds + LDS_BYTES - 16);
    if (threadIdx.x == 0) { xbw[0] = 0u; xbw[1] = 0u; xbw[2] = 0u; xbw[3] = 0u; }
    __syncthreads();
    XcdBarrier bar = xcd_barrier_post(p.bar, xbw);

#if PHMASK & (1 << 0)
    DUP(0) {
    {
        PHASE_IDS
        LAS float* scr = (LAS float*)lds;
        transpose_w<1>(p.w_gu1, D, 2 * F, p.Wgu1t, 2 * F, scr, tid, (int)blockIdx.x, (int)gridDim.x);
        transpose_w<0>(p.w_dn1, F, D, p.Wdn1t, D, scr, tid, (int)blockIdx.x, (int)gridDim.x);
        for (size_t e = gtid; e < (size_t)1024 * 64; e += gthreads) { const size_t ch = e >> 6, k = e & 63; p.Lw2t[e] = (bf16)(cvt_pk_bf16(p.w2[k * 1024 + ch], 0.f) & 0xffffu); p.La2t[e] = (bf16)(cvt_pk_bf16(p.a2[k * 1024 + ch], 0.f) & 0xffffu); }
        for (size_t e = gtid; e < (size_t)1024 * 160; e += gthreads) { const size_t ch = e / 160, k = e % 160; p.Lg2t[e] = (bf16)(cvt_pk_bf16(p.g2[k * 1024 + ch], 0.f) & 0xffffu); }
        for (size_t i = gtid; i < (size_t)MP * D / 8; i += gthreads) {
            const size_t row = i >> 8, c = (i & 255) * 8;
            u32x4 w = {0u, 0u, 0u, 0u};
            if (row < MT) { const float* s = (row < SEQ ? p.x_p + row * D : p.x_s + (row - SEQ) * D) + c; const float4 a = *(const float4*)s, b = *(const float4*)(s + 4);
                w.x = cvt_pk_bf16(a.x, a.y); w.y = cvt_pk_bf16(a.z, a.w); w.z = cvt_pk_bf16(b.x, b.y); w.w = cvt_pk_bf16(b.z, b.w); }
            *(u32x4*)(p.XAb + row * D + c) = w;
        }
        { const u32x4 z = {0u, 0u, 0u, 0u};
          for (size_t i = gtid; i < (size_t)128 * D / 8; i += gthreads) { *(u32x4*)(p.H1b + (size_t)MT * D + i * 8) = z; *(u32x4*)(p.H2b + (size_t)MT * D + i * 8) = z; }
          for (size_t i = gtid; i < (size_t)128 * 1024 / 8; i += gthreads) { *(u32x4*)(p.ROb + (size_t)MT * 1024 + i * 8) = z; *(u32x4*)(p.Ob + (size_t)MT * 1024 + i * 8) = z; } }
        for (size_t i = gtid; i < (size_t)NS * D / 4; i += gthreads) *(f32x4*)(p.PRE + (size_t)SEQ * D + i * 4) = *(const f32x4*)(p.x_s + i * 4) * ALPHA;
        { const u32x4 z = {0u, 0u, 0u, 0u};
          for (size_t i = gtid; i < (size_t)4 * 512 * 64 / 8; i += gthreads) { *(u32x4*)(p.KCb + i * 8) = z; *(u32x4*)(p.VCtb + i * 8) = z; } }
    }
    xcd_barrier(bar);
        }
#endif
#if PHMASK & (1 << 1)
    DUP(1) {
    { pg8::Gemm g{p.XAb, p.Wgu1t, MP, 2 * F, D}; pg8::StaticOrder S; S.init(MP, 2 * F, (int)gridDim.x, (int)blockIdx.x); EpiSwiglu E{p.ACTb};
      pg8::gemm_phase<EpiSwiglu, pg8::StaticOrder, true, true>(lds, g, S, E); }
    if (blockIdx.x >= 172) { PHASE_IDS __syncthreads(); transpose_w<2>(p.w_in, D, INC, p.Wint, NIN, (LAS float*)lds, tid, (int)blockIdx.x - 172, (int)gridDim.x - 172); }
    xcd_barrier(bar);
    }
    #endif
#if PHMASK & (1 << 2)
    DUP(2) {
    { pg8::Gemm g{p.ACTb, p.Wdn1t, SEQ, D, F}; PieceOrder S; S.init(SEQ, D, (int)gridDim.x, (int)blockIdx.x); S.npieces = 176; S.ppt = 22; S.pkt = 4; EpiResid E{p.PRE, p.x_p, p.x_s, 0.5f, p.SLAB, 22, nullptr, nullptr, nullptr};
      pg8::gemm_phase<EpiResid, PieceOrder, true, true>(lds, g, S, E); }
    xcd_barrier(bar);
    }
    #endif
#if PHMASK & (1 << 3)
    DUP(3) {
    { PHASE_IDS ln_rows<false>(p.PRE, p.ln1_g, p.ln1_b, p.LNST, p.H1b, p.o_y_p, p.o_y_s, p.SLAB, 22, gw, nw, lane, wid, (LAS float*)lds); }
    xcd_barrier(bar);
    }
    #endif
#if PHMASK & (1 << 4)
    DUP(4) {
    { pg8::Gemm g{p.H1b, p.Wint, MP, NIN, D}; pg8::StaticOrder S; S.init(MP, NIN, (int)gridDim.x, (int)blockIdx.x);
      EpiWin E{p.UA, p.Qb, p.Kc, p.Vc, p.GMb, p.o_cmp_p, p.o_sel_p, p.o_win_p, p.o_shift_p, p.o_cmp_s, p.o_sel_s, p.o_win_s, p.o_shift_s};
      pg8::gemm_phase<EpiWin, pg8::StaticOrder, true, true>(lds, g, S, E); }
    if (blockIdx.x >= 40) { PHASE_IDS __syncthreads(); const int wg = (int)blockIdx.x - 40, nwg = (int)gridDim.x - 40; LAS float* scr = (LAS float*)lds;
        transpose_w<0>(p.w_up_a, 1024, D, p.Wupat, D, scr, tid, wg, nwg); transpose_w<0>(p.w_up_b, 1024, D, p.Wupbt, D, scr, tid, wg, nwg); transpose_w<0>(p.w_o, D, D, p.Wot, D, scr, tid, wg, nwg);
        transpose_w<1>(p.w_gu2, D, 2 * F, p.Wgu2t, F, scr, tid, wg, nwg); }
    xcd_barrier(bar);
    }
    #endif
#if PHMASK & (1 << 5)
    DUP(5) {
#ifndef DUP_PREP
#define DUP_PREP 1
#endif
#ifndef DUP_SNSA
#define DUP_SNSA 1
#endif
#ifndef DUP_CV
#define DUP_CV 1
#endif
    { PHASE_IDS for (int r2 = 0; r2 < DUP_PREP; ++r2) rwkv_prep_phase(p, lds, tid);
      if (blockIdx.x >= 224) compress_phase<false>(p, lds, tid, (int)blockIdx.x - 224, 32);
      else if (blockIdx.x >= 64) vtrans_phase(p, (LAS bf16*)lds, tid, (int)blockIdx.x - 64, 160);
    }
    xcd_barrier(bar);
    }
    #endif
#if PHMASK & (1 << 6)
    DUP(6) {
    { PHASE_IDS
#ifndef DUP_SCAN
#define DUP_SCAN 1
#endif
#ifndef DUP_NSA
#define DUP_NSA 1
#endif
#ifndef SCAN_ALONE
#define SCAN_ALONE 0
#endif
    volatile LAS unsigned* scan_done = (volatile LAS unsigned*)(lds + LDS_BYTES - 32);
    if (tid == 0) *scan_done = 0u;
    __syncthreads();
    if (blockIdx.x < 64 && wid < 4) { __builtin_amdgcn_s_setprio(3); for (int r2 = 0; r2 < DUP_SCAN; ++r2) rwkv_scan_fast<false>(p, blockIdx.x * 4 + wid, lane, (LAS float*)(lds + 32768) + wid * 2560); __builtin_amdgcn_s_setprio(0);
        if (lane == 0) (void)__hip_atomic_fetch_add((LAS unsigned*)(lds + LDS_BYTES - 32), 1u, __ATOMIC_RELAXED, __HIP_MEMORY_SCOPE_WORKGROUP); }
    else { const int nsw = blockIdx.x < 64 ? blockIdx.x * 4 + (wid - 4) : 256 + (blockIdx.x - 64) * 8 + wid, nns = 256 + ((int)gridDim.x - 64) * 8;
           for (int it = nsw; it < 32 * 256; it += nns) rwkv_scan_fast<true>(p, it, lane, (LAS float*)(lds + 32768) + wid * 2560);
           if (blockIdx.x < 64) {
               for (size_t i = (size_t)(blockIdx.x * 4 + (wid - 4)) * 64 + lane; i < (size_t)32 * 508 * 128; i += (size_t)256 * 64) {
                   const size_t b = i / (508 * 128), rem = i % (508 * 128);
                   *(float4*)(p.o_win_s + b * 512 * 512 + rem * 4) = *(const float4*)(p.state_win + b * 512 * 512 + 4 * 512 + rem * 4);
               }
               while (*scan_done < 4u) __builtin_amdgcn_s_sleep(32); } }
    { LAS float* impL = (LAS float*)(lds + wid * 3072); LAS int* selL = (LAS int*)(lds + wid * 3072 + 2048); LAS int* stepL = (LAS int*)(lds + wid * 3072 + 2304);
      for (int r2 = 0; r2 < DUP_NSA; ++r2) {
          const int kv0 = (int)(xb_xcc_id() & 3u);
          for (int kk = 0; kk < 4 && !(SCAN_ALONE && blockIdx.x < 64 && wid >= 4); ++kk) {
              const int kvq = (kv0 + kk) & 3;
              for (;;) {
                  int idx = 0;
                  if (lane == 0) idx = (int)__hip_atomic_fetch_add(p.ctl + 16 * (rep_ + 2 * r2) + kvq, 1u, __ATOMIC_RELAXED, __HIP_MEMORY_SCOPE_AGENT);
                  idx = __builtin_amdgcn_readfirstlane(idx);
                  if (idx >= 2048) break;
                  nsa_prompt_item(p, (idx << 2) | kvq, lane, impL, selL, stepL);
              }
          }
      } }
    if (blockIdx.x >= 64) {
        __syncthreads();
        const int wg = (int)blockIdx.x - 64, nwg = (int)gridDim.x - 64;
        LAS float* scr = (LAS float*)lds;
        compress_phase<true>(p, lds, tid, wg, nwg);
        asm volatile("s_waitcnt vmcnt(0)" ::: "memory");
        __syncthreads();
        if (tid == 0) {
            __builtin_amdgcn_fence(__ATOMIC_RELEASE, "agent");
            asm volatile("s_waitcnt vmcnt(0)" ::: "memory");
            (void)__hip_atomic_fetch_add(p.ctl + 60, 1u, __ATOMIC_RELAXED, __HIP_MEMORY_SCOPE_AGENT);
            unsigned spins = 0;
            while (__hip_atomic_load(p.ctl + 60, __ATOMIC_RELAXED, __HIP_MEMORY_SCOPE_AGENT) < (unsigned)nwg && ++spins < (1u << 22)) __builtin_amdgcn_s_sleep(2);
            __builtin_amdgcn_fence(__ATOMIC_ACQUIRE, "agent");
            asm volatile("s_waitcnt vmcnt(0)" ::: "memory");
        }
        __syncthreads();
        for (int r2 = 0; r2 < DUP_SNSA; ++r2) nsa_sample_phase(p, lds, tid, wg, nwg);
    } }
    xcd_barrier(bar);
    }
#endif
#if PHMASK & (1 << 7)
    DUP(7) {
#ifdef NSA_CHECK
    { PHASE_IDS nsa_phase<false>(p, lds, tid); }
    xcd_barrier(bar);
    { PHASE_IDS float num = 0.f, den = 0.f;
      for (size_t i = gtid; i < (size_t)SEQ * 1024; i += gthreads) { const float a = bf_at(p.Ob + i), b = p.Ob2[i], d = a - b; num += d * d; den += b * b; }
      num = wave_sum(num); den = wave_sum(den);
      if (lane == 0) { atomicAdd((float*)(p.ctl + 16), num); atomicAdd((float*)(p.ctl + 17), den); } }
    xcd_barrier(bar);
#endif
    { PHASE_IDS rwkv_post_phase(p, tid); }
    xcd_barrier(bar);
    }
#endif
#if PHMASK & (1 << 8)
    DUP(8) {
    { pg8::Gemm g{p.ROb, p.Wupat, SEQ, D, 1024}; PieceOrder S; S.init(SEQ, D, (int)gridDim.x, (int)blockIdx.x); S.npieces = 32; S.ppt = 4; S.pkt = 4; EpiUp<false> E{p.MIXA, p.MIXb, p.GMb, p.SLAB, 0};
      pg8::gemm_phase<EpiUp<false>, PieceOrder, true, true>(lds, g, S, E); }
    { pg8::Gemm g{p.Ob, p.Wupbt, SEQ, D, 1024}; PieceOrder S; S.init(SEQ, D, (int)gridDim.x, (int)blockIdx.x); S.npieces = 32; S.ppt = 4; S.pkt = 4; EpiUp<true> E{p.MIXA, p.MIXb, p.GMb + D, p.SLAB, 1};
      pg8::gemm_phase<EpiUp<true>, PieceOrder, true, true>(lds, g, S, E); }
    if (blockIdx.x < 32) {
        asm volatile("s_waitcnt vmcnt(0)" ::: "memory");
        __syncthreads();
        if (threadIdx.x == 0) { __builtin_amdgcn_fence(__ATOMIC_RELEASE, "agent"); asm volatile("s_waitcnt vmcnt(0)" ::: "memory"); (void)__hip_atomic_fetch_add(p.ctl + 59, 1u, __ATOMIC_RELAXED, __HIP_MEMORY_SCOPE_AGENT); }
    } else if (blockIdx.x < 64) {
        if (threadIdx.x == 0) { unsigned spins = 0;
            while (__hip_atomic_load(p.ctl + 59, __ATOMIC_RELAXED, __HIP_MEMORY_SCOPE_AGENT) < 32u * (1u + (unsigned)rep_) && ++spins < (1u << 22)) __builtin_amdgcn_s_sleep(2);
            __builtin_amdgcn_fence(__ATOMIC_ACQUIRE, "agent"); asm volatile("s_waitcnt vmcnt(0)" ::: "memory"); }
        __syncthreads();
        for (int q = ((int)blockIdx.x - 32) * NTHR + (int)threadIdx.x; q < 128 * 256; q += 32 * NTHR) {
            const int sr = q >> 8, c8 = (q & 255) * 8, tile = c8 >> 8, cin = c8 & 255;
            f32x4 a0 = {0.f, 0.f, 0.f, 0.f}, a1 = a0;
#pragma unroll
            for (int k8 = 0; k8 < 8; ++k8) { const float* sl = p.SLAB + ((size_t)(((k8 >> 2) * 8 + tile) * 4 + (k8 & 3)) * 128 + sr) * 256 + cin; a0 += *(const f32x4*)sl; a1 += *(const f32x4*)(sl + 4); }
            u32x4 w; w.x = cvt_pk_bf16(a0[0], a0[1]); w.y = cvt_pk_bf16(a0[2], a0[3]); w.z = cvt_pk_bf16(a1[0], a1[1]); w.w = cvt_pk_bf16(a1[2], a1[3]);
            *(u32x4*)(p.MIXb + (size_t)(SEQ + sr) * D + c8) = w;
        }
    } else { PHASE_IDS __syncthreads(); transpose_w<3>(p.w_gu2, D, 2 * F, p.Wgu2t + (size_t)F * D, F, (LAS float*)lds, tid, (int)blockIdx.x - 64, (int)gridDim.x - 64); }
    xcd_barrier(bar);
    }
    #endif
#if PHMASK & (1 << 9)
    DUP(9) {
    { pg8::Gemm g{p.MIXb, p.Wot, SEQ, D, D}; PieceOrder S; S.init(SEQ, D, (int)gridDim.x, (int)blockIdx.x); S.npieces = 64; S.ppt = 8; S.pkt = 4; EpiResid E{p.PRE, p.PRE, p.PRE, 1.0f, p.SLAB, 8, p.LNST, p.ln1_g, p.ln1_b};
      pg8::gemm_phase<EpiResid, PieceOrder, true, true>(lds, g, S, E); }
    xcd_barrier(bar);
    }
    #endif
#if PHMASK & (1 << 10)
    DUP(10) {
    { PHASE_IDS ln_rows<false>(p.PRE, p.ln2_g, p.ln2_b, p.LNST, p.H2b, p.o_y_p, p.o_y_s, p.SLAB, 8, gw, nw, lane, wid, (LAS float*)lds); }
    xcd_barrier(bar);
    }
    #endif
#if PHMASK & (1 << 11)
    DUP(11) {
    { pg8::Gemm g{p.H2b, p.Wgu2t, MP, 2 * F, D}; pg8::StaticOrder S; S.init(MP, 2 * F, (int)gridDim.x, (int)blockIdx.x); EpiSwiglu E{p.ACTb};
      pg8::gemm_phase<EpiSwiglu, pg8::StaticOrder, true, true>(lds, g, S, E); }
    if (blockIdx.x >= 172) { PHASE_IDS __syncthreads(); transpose_w<0>(p.w_dn2, F, D, p.Wdn2t, D, (LAS float*)lds, tid, (int)blockIdx.x - 172, (int)gridDim.x - 172); }
    xcd_barrier(bar);
    }
    #endif
#if PHMASK & (1 << 12)
    DUP(12) {
    { pg8::Gemm g{p.ACTb, p.Wdn2t, SEQ, D, F}; PieceOrder S; S.init(SEQ, D, (int)gridDim.x, (int)blockIdx.x); S.npieces = 176; S.ppt = 22; S.pkt = 4; EpiResid E{p.PRE, p.PRE, p.PRE, 0.5f, p.SLAB, 22, p.LNST, p.ln2_g, p.ln2_b};
      pg8::gemm_phase<EpiResid, PieceOrder, true, true>(lds, g, S, E); }
    xcd_barrier(bar);
    }
    #endif
#if PHMASK & (1 << 13)
    DUP(13) {
    { PHASE_IDS ln_rows<true>(p.PRE, p.ln3_g, p.ln3_b, p.LNST, p.H2b, p.o_y_p, p.o_y_s, p.SLAB, 22, gw, nw, lane, wid, (LAS float*)lds); }
#ifdef NSA_CHECK
    { const float num = __hip_atomic_load((float*)(p.ctl + 16), __ATOMIC_RELAXED, __HIP_MEMORY_SCOPE_AGENT), den = __hip_atomic_load((float*)(p.ctl + 17), __ATOMIC_RELAXED, __HIP_MEMORY_SCOPE_AGENT);
      if (!(num <= NSA_CHECK_THR * den) && blockIdx.x == 0 && threadIdx.x == 0) p.o_y_s[0] = __builtin_nanf(""); }
#endif
    }
#endif
}
}

extern "C" void kernel_launch(void* const* d_in, const int* in_sizes, int n_in, void* d_out, int out_size, void* d_ws, size_t ws_size, hipStream_t stream) {
    static int grid = 0;
    if (grid == 0) {
        int dev = 0, cus = 0;
        if (hipGetDevice(&dev) != hipSuccess || hipDeviceGetAttribute(&cus, hipDeviceAttributeMultiprocessorCount, dev) != hipSuccess) { fprintf(stderr, "kernel_launch: device query failed\n"); grid = -1; return; }
        if (hipFuncSetAttribute((const void*)mega_fwd, hipFuncAttributeMaxDynamicSharedMemorySize, LDS_BYTES) != hipSuccess) { fprintf(stderr, "kernel_launch: hipFuncSetAttribute failed\n"); grid = -1; return; }
        int per_cu = 0;
        if (hipOccupancyMaxActiveBlocksPerMultiprocessor(&per_cu, (const void*)mega_fwd, NTHR, LDS_BYTES) != hipSuccess || per_cu < 1) { fprintf(stderr, "kernel_launch: occupancy query says %d blocks per CU\n", per_cu); }
        (void)hipGetLastError();
        grid = cus;
    }
    if (grid < 0) return;
    Params p{};
    const float* const* in = (const float* const*)d_in;
    p.x_p = in[0]; p.x_s = in[1]; p.cache_cmp = in[2]; p.cache_sel = in[3]; p.pt = (const int*)d_in[4]; p.state_win = in[5]; p.state_rwkv = in[6]; p.state_shift = in[7];
    p.ln1_g = in[8]; p.ln1_b = in[9]; p.w_gu1 = in[10]; p.w_dn1 = in[11]; p.w_in = in[12]; p.mu = in[13]; p.w0 = in[14]; p.w2 = in[15]; p.a0 = in[16]; p.a2 = in[17]; p.g2 = in[18];
    p.k_k = in[19]; p.k_a = in[20]; p.r_k = in[21]; p.rln_w = in[22]; p.rln_b = in[23]; p.w_up_a = in[24]; p.cmp_pe = in[25]; p.cmp_wa = in[26]; p.cmp_wb = in[27]; p.w_up_b = in[28]; p.w_o = in[29];
    p.ln2_g = in[30]; p.ln2_b = in[31]; p.w_gu2 = in[32]; p.w_dn2 = in[33]; p.ln3_g = in[34]; p.ln3_b = in[35];
    float* out = (float*)d_out; size_t off = 0;
    p.o_y_p = out + off; off += (size_t)SEQ * D;
    p.o_y_s = out + off; off += (size_t)NS * D;
    p.o_cmp_p = out + off; off += (size_t)SEQ * 512;
    p.o_sel_p = out + off; off += (size_t)SEQ * 512;
    p.o_win_p = out + off; off += (size_t)512 * 512;
    p.o_state_p = out + off; off += (size_t)16 * 4096;
    p.o_shift_p = out + off; off += RCOLS;
    p.o_cmp_s = out + off; off += (size_t)NS * 512;
    p.o_sel_s = out + off; off += (size_t)NS * 512;
    p.o_win_s = out + off; off += (size_t)32 * 512 * 512;
    p.o_state_s = out + off; off += (size_t)32 * 16 * 4096;
    p.o_shift_s = out + off; off += (size_t)32 * RCOLS;

    unsigned char* ws = (unsigned char*)d_ws; size_t w = 0;
    auto alloc = [&](size_t bytes) { unsigned char* q = ws + w; w += (bytes + 255) & ~(size_t)255; return q; };
    p.bar = (unsigned*)alloc((XCD_BAR_WORDS + 64) * sizeof(unsigned)); p.ctl = p.bar + XCD_BAR_WORDS;
    p.XAb = (bf16*)alloc((size_t)MP * D * 2); p.ACTb = (bf16*)alloc((size_t)MP * F * 2); p.H1b = (bf16*)alloc((size_t)MP * D * 2); p.H2b = (bf16*)alloc((size_t)MP * D * 2);
    p.Qb = (bf16*)alloc((size_t)MP * 1024 * 2); p.Kc = (bf16*)alloc((size_t)12 * MP * 64 * 2); p.Vc = (bf16*)alloc((size_t)12 * MP * 64 * 2); p.GMb = (bf16*)alloc((size_t)MP * 4096 * 2);
    p.Vtb = (bf16*)alloc((size_t)8 * 128 * 4096 * 2 + 8192); p.KCb = (bf16*)alloc((size_t)4 * 512 * 64 * 2); p.VCtb = (bf16*)alloc((size_t)4 * 512 * 64 * 2);
    p.ROb = (bf16*)alloc((size_t)MP * 1024 * 2); p.Ob = (bf16*)alloc((size_t)MP * 1024 * 2); p.MIXb = (bf16*)alloc((size_t)MP * D * 2);
    p.Wgu1t = (bf16*)alloc((size_t)2 * F * D * 2); p.Wdn1t = (bf16*)alloc((size_t)D * F * 2); p.Wint = (bf16*)alloc((size_t)NIN * D * 2);
    p.Wupat = (bf16*)alloc((size_t)D * 1024 * 2); p.Wupbt = (bf16*)alloc((size_t)D * 1024 * 2); p.Wot = (bf16*)alloc((size_t)D * D * 2);
    p.Wgu2t = (bf16*)alloc((size_t)2 * F * D * 2); p.Wdn2t = (bf16*)alloc((size_t)D * F * 2);
    p.Lw2t = (bf16*)alloc((size_t)1024 * 64 * 2); p.La2t = (bf16*)alloc((size_t)1024 * 64 * 2); p.Lg2t = (bf16*)alloc((size_t)1024 * 160 * 2);
    p.PRE = (float*)alloc((size_t)MP * D * 4); p.LNST = (float*)alloc((size_t)MP * 2 * 4);
    p.UA = (float*)alloc((size_t)MP * UAW * 4); p.MIXA = (float*)alloc((size_t)MP * D * 4); p.SLAB = (float*)alloc((size_t)8 * 22 * 128 * 256 * 4);
    p.SC = (float*)alloc((size_t)MT * SCR * 4); p.YS = (float*)alloc((size_t)MT * 2048 * 4); p.C12 = (float*)alloc((size_t)MT * 64 * 4); p.G = (float*)alloc((size_t)MT * 1024 * 4);
    p.KCVs = (float*)alloc((size_t)32 * 511 * 512 * 4);
#ifdef NSA_CHECK
    p.KCVp = (float*)alloc((size_t)511 * 512 * 4); p.Ob2 = (float*)alloc((size_t)SEQ * 1024 * 4);
#endif
    if (w > ws_size) { fprintf(stderr, "kernel_launch: workspace too small: need %zu, have %zu\n", w, ws_size); return; }
    if (hipMemsetAsync(p.bar, 0, (XCD_BAR_WORDS + 64) * sizeof(unsigned), stream) != hipSuccess) { fprintf(stderr, "kernel_launch: memset failed\n"); return; }
    hipLaunchKernelGGL(mega_fwd, dim3(grid), dim3(NTHR), LDS_BYTES, stream, p);
    const hipError_t le = hipPeekAtLastError();
    if (le != hipSuccess) fprintf(stderr, "kernel_launch: launch failed: %s\n", hipGetErrorName(le));
}
```

```cpp
#include <hip/hip_runtime.h>
#include <cstdio>
#include <cstdint>
#define XB_TMO      128
#define XB_XCNT(j)  (256  + 64 * (j))
#define XB_XSUB(j)  (1280 + 64 * (j))
#define XB_XGEN(j)  (2304 + 64 * (j))
#define XB_TOP      3328
#define XB_TOPGEN   3392
#define XCD_BAR_WORDS 3456
#define XB_SPIN_CAP (1u << 18)
#define LAS __attribute__((address_space(3)))

__device__ __forceinline__ unsigned xb_ld(unsigned* p)              { return __hip_atomic_load(p, __ATOMIC_RELAXED, __HIP_MEMORY_SCOPE_AGENT); }
__device__ __forceinline__ unsigned xb_add(unsigned* p, unsigned v) { return __hip_atomic_fetch_add(p, v, __ATOMIC_RELAXED, __HIP_MEMORY_SCOPE_AGENT); }
__device__ __forceinline__ unsigned xb_xcc_id() { return (unsigned)__builtin_amdgcn_s_getreg((3 << 11) | 20) & 0xFu; }
#define XB_SPIN(cond, bar) do { unsigned _sp = 0; while (cond) { __builtin_amdgcn_s_sleep(1); \
    if ((++_sp & 255u) == 0u) { if (xb_ld(&(bar)[XB_TMO])) break; if (_sp > XB_SPIN_CAP) { atomicAdd(&(bar)[XB_TMO], 1u); break; } } } } while (0)

struct XcdBarrier {
    unsigned* bar; unsigned x;
    volatile LAS unsigned* st;
};

__device__ __forceinline__ XcdBarrier xcd_barrier_post(unsigned* bar, volatile LAS unsigned* st) {
    XcdBarrier b; b.bar = bar; b.x = xb_xcc_id(); b.st = st;
    if (threadIdx.x == 0) (void)xb_add(&bar[XB_XCNT(b.x)], 1u);
    return b;
}
__device__ __forceinline__ void xcd_barrier_complete(unsigned* bar, unsigned x, unsigned& nloc, unsigned& nx) {
    const unsigned G = gridDim.x * gridDim.y * gridDim.z;
    unsigned sum, cnt, mine, sp = 0u;
    for (;;) {
        sum = 0u; cnt = 0u; mine = 0u;
#pragma unroll
        for (unsigned j = 0; j < 16; ++j) { const unsigned c = xb_ld(&bar[XB_XCNT(j)]); sum += c; cnt += (c > 0u) ? 1u : 0u; mine = (j == x) ? c : mine; }
        if (sum == G) break;
        __builtin_amdgcn_s_sleep(1);
        if ((++sp & 255u) == 0u) { if (xb_ld(&bar[XB_TMO])) break; if (sp > XB_SPIN_CAP) { atomicAdd(&bar[XB_TMO], 1u); break; } }
    }
    nloc = mine > 0u ? mine : 1u; nx = cnt > 0u ? cnt : 1u;
}

__device__ __forceinline__ void xcd_barrier(const XcdBarrier& b) {
    asm volatile("s_waitcnt vmcnt(0)" ::: "memory");
    __syncthreads();
    if (threadIdx.x == 0) {
        unsigned* bar = b.bar;
        __builtin_amdgcn_s_waitcnt(0);
        unsigned nloc = b.st[0], nx = b.st[1];
        if (nloc == 0u) { xcd_barrier_complete(bar, b.x, nloc, nx); b.st[0] = nloc; b.st[1] = nx; }
        const unsigned old = xb_add(&bar[XB_XSUB(b.x)], 1u);
        const unsigned gen = old / nloc;
        if (old + 1u == (gen + 1u) * nloc) {
            __builtin_amdgcn_fence(__ATOMIC_RELEASE, "agent");
            asm volatile("s_waitcnt vmcnt(0)" ::: "memory");
            const unsigned og = xb_add(&bar[XB_TOP], 1u);
            const unsigned tg = og / nx;
            if (og + 1u == (tg + 1u) * nx) xb_add(&bar[XB_TOPGEN], 1u);
            else XB_SPIN(xb_ld(&bar[XB_TOPGEN]) == tg, bar);
            __builtin_amdgcn_fence(__ATOMIC_ACQUIRE, "agent");
            xb_add(&bar[XB_XGEN(b.x)], 1u);
            asm volatile("s_waitcnt vmcnt(0)" ::: "memory");
        } else {
            XB_SPIN(xb_ld(&bar[XB_XGEN(b.x)]) == gen, bar);
            __builtin_amdgcn_fence(__ATOMIC_ACQUIRE, "agent");
            asm volatile("s_waitcnt vmcnt(0)" ::: "memory");
        }
    }
    __syncthreads();
}

namespace pg8 {
#define PG8_LAS __attribute__((address_space(3)))
typedef unsigned short bf16_t;
typedef short bf16x8 __attribute__((ext_vector_type(8)));
typedef float f32x4 __attribute__((ext_vector_type(4)));
typedef unsigned u32x4 __attribute__((ext_vector_type(4)));
constexpr int BM = 256, BK = 64, HALF = 128, HTB = HALF * BK * 2  , STAGE_BYTES = 8 * HTB, NXCD = 8, WGM = 8;

__host__ __device__ __forceinline__ int lds_byte(int r, int c) { const int st = (r >> 4) * 2 + (c >> 5), rr = r & 15, cc = c & 31, ob = rr * 64 + cc * 2; return st * 1024 + (ob ^ (((ob >> 9) & 1) << 5)); }
__host__ __device__ __forceinline__ void stage_rc(int b, int& R, int& C) { const int st = b / 1024, sb = b % 1024, swz = sb ^ (((sb >> 9) & 1) << 5); R = (st >> 1) * 16 + swz / 64; C = (st & 1) * 32 + (swz % 64) / 2; }
__host__ __device__ __forceinline__ int perm32(int rho) { const int n = rho >> 4, i = rho & 15; return 8 * (i >> 2) + 4 * n + (i & 3); }

struct Unit { int pm, pn, kt0, nkt; };
struct Gemm { const bf16_t* A; const bf16_t* Bt; int M, N, K; };

struct StaticOrder {
    int nM, nN, nwg, G, c;
    __host__ __device__ void init(int M, int N, int G_, int c_) { nM = M / BM; nN = N / BM; nwg = nM * nN; G = G_; c = c_; }
    __host__ __device__ bool next(int i, Unit& u) const {
        const long L = (long)i * G + c; if (L >= nwg) return false;
        int wgid = (int)L; { const int q = nwg / NXCD, r = nwg % NXCD, xcd = wgid % NXCD, off = wgid / NXCD; wgid = (xcd < r ? xcd * (q + 1) : r * (q + 1) + (xcd - r) * q) + off; }
        const int nig = WGM * nN, gid = wgid / nig, fm = gid * WGM, gsz = (nM - fm) < WGM ? (nM - fm) : WGM;
        u.pm = fm + ((wgid % nig) % gsz); u.pn = (wgid % nig) / gsz; u.kt0 = 0; u.nkt = 0; return true;
    }
    __device__ __forceinline__ void a_ready(const Unit&) const {}
    __device__ __forceinline__ void done(const Unit&) const {}
};

__device__ __forceinline__ unsigned cvt_pk_bf16(float lo, float hi) { unsigned r; asm volatile("v_cvt_pk_bf16_f32 %0, %1, %2" : "=v"(r) : "v"(lo), "v"(hi)); return r; }
typedef float f32x2 __attribute__((ext_vector_type(2)));
template <class Epi, class Sched, bool ALIGN_EPI = false, bool SP2 = false>
__device__ __forceinline__ void gemm_phase(PG8_LAS unsigned char* lds, const Gemm g, const Sched& S, const Epi& E) {
    int tid_o = threadIdx.x; asm volatile("" : "+v"(tid_o));
    const int tid = tid_o, wid = __builtin_amdgcn_readfirstlane(tid >> 6), lane = tid & 63, wr = wid >> 2, wc = wid & 3, fr = lane & 15, fq = lane >> 4;
    const int K = g.K, nt = K / BK;
    unsigned voffA[2], voffB[2];
#pragma unroll
    for (int i = 0; i < 2; ++i) { int R, C; stage_rc(tid * 16 + i * 8192, R, C); const int Rb = Epi::PERM ? ((R & ~31) + perm32(R & 31)) : R;
        voffA[i] = (unsigned)(R * K + C) * 2u; voffB[i] = (unsigned)(Rb * K + C) * 2u; }
    const size_t kstep = (size_t)(BK * 2);
    const size_t hstep = (size_t)HALF * K * 2;
    const size_t tstep = 2 * hstep;
    const unsigned ldsw = (unsigned)wid * 1024u;
    const int aoff = lds_byte(wr * 64 + fr, fq * 8), boff = lds_byte(wc * 32 + fr, fq * 8);
#define PG8_SA(b, h) (((b) * 2 + (h)) * HTB)
#define PG8_SB(b, h) ((4 + (b) * 2 + (h)) * HTB)
#define PG8_STAGE(bufoff, gbase, voff) do { _Pragma("unroll") for (int _i = 0; _i < 2; ++_i) \
        __builtin_amdgcn_global_load_lds((const unsigned*)((const char*)(gbase) + (voff)[_i]), (PG8_LAS unsigned*)(lds + (bufoff) + ldsw + _i * 8192), 16, 0, 0); } while (0)
#define PG8_LDA(dst, b, h) do { _Pragma("unroll") for (int m = 0; m < 4; ++m) _Pragma("unroll") for (int k = 0; k < 2; ++k) dst[m][k] = *(const PG8_LAS bf16x8*)(lds + PG8_SA(b, h) + aoff + m * 2048 + k * 1024); } while (0)
#define PG8_LDB(dst, b, h) do { _Pragma("unroll") for (int n = 0; n < 2; ++n) _Pragma("unroll") for (int k = 0; k < 2; ++k) dst[n][k] = *(const PG8_LAS bf16x8*)(lds + PG8_SB(b, h) + boff + n * 2048 + k * 1024); } while (0)
#define PG8_MMA(ai, bj, At, Bt) do { __builtin_amdgcn_s_setprio(1); _Pragma("unroll") for (int m = 0; m < 4; ++m) _Pragma("unroll") for (int n = 0; n < 2; ++n) _Pragma("unroll") for (int k = 0; k < 2; ++k) \
        acc[ai][bj][m][n] = __builtin_amdgcn_mfma_f32_16x16x32_bf16(Bt[n][k], At[m][k], acc[ai][bj][m][n], 0, 0, 0); __builtin_amdgcn_s_setprio(0); } while (0)
#define PG8_WAIT_V(n) asm volatile("s_waitcnt vmcnt(" #n ")" ::: "memory")
#define PG8_WAIT_L(n) asm volatile("s_waitcnt lgkmcnt(" #n ")" ::: "memory")
#define PG8_BAR __builtin_amdgcn_s_barrier()
#define PG8_SCHED __builtin_amdgcn_sched_barrier(0)
    Unit cur, nxt; int ui = 0;
    if (!S.next(0, cur)) return;
    f32x4 acc[2][2][4][2];
#pragma unroll
    for (int a = 0; a < 2; ++a)
#pragma unroll
        for (int b = 0; b < 2; ++b)
#pragma unroll
            for (int m = 0; m < 4; ++m)
#pragma unroll
                for (int n = 0; n < 2; ++n) acc[a][b][m][n] = (f32x4){0.f, 0.f, 0.f, 0.f};
    bf16x8 At[4][2], B0[2][2], B1[2][2];
    const char* cA = (const char*)g.A + (size_t)cur.pm * tstep + (size_t)cur.kt0 * kstep; const char* cB = (const char*)g.Bt + (size_t)cur.pn * tstep + (size_t)cur.kt0 * kstep;
    S.a_ready(cur);
    if constexpr (SP2) {
        PG8_STAGE(PG8_SB(0, 0), cB, voffB); PG8_STAGE(PG8_SB(0, 1), cB + hstep, voffB); PG8_STAGE(PG8_SA(0, 0), cA, voffA); PG8_STAGE(PG8_SA(0, 1), cA + hstep, voffA);
        if (wr == 1) PG8_BAR;
        PG8_WAIT_V(2); PG8_BAR;
        PG8_STAGE(PG8_SB(1, 0), cB + kstep, voffB); PG8_STAGE(PG8_SA(1, 0), cA + kstep, voffA); PG8_STAGE(PG8_SB(1, 1), cB + hstep + kstep, voffB);
        PG8_WAIT_V(6); PG8_BAR;
    } else {
        PG8_STAGE(PG8_SB(0, 0), cB, voffB); PG8_STAGE(PG8_SA(0, 0), cA, voffA); PG8_STAGE(PG8_SB(0, 1), cB + hstep, voffB); PG8_STAGE(PG8_SA(0, 1), cA + hstep, voffA);
        if (wr == 1) PG8_BAR;
        PG8_WAIT_V(4); PG8_BAR;
        PG8_STAGE(PG8_SB(1, 0), cB + kstep, voffB); PG8_STAGE(PG8_SA(1, 0), cA + kstep, voffA); PG8_STAGE(PG8_SB(1, 1), cB + hstep + kstep, voffB);
        PG8_WAIT_V(6); PG8_BAR;
    }
    for (;;) {
        const bool has_next = S.next(ui + 1, nxt);
        const char* nA = has_next ? (const char*)g.A + (size_t)nxt.pm * tstep + (size_t)nxt.kt0 * kstep : cA; const char* nB = has_next ? (const char*)g.Bt + (size_t)nxt.pn * tstep + (size_t)nxt.kt0 * kstep : cB;
        const int ntc = cur.nkt ? cur.nkt : nt;
        for (int t = 0; t < ntc; t += 2) {
            const bool last = (t == ntc - 2);
            const char* a1 = cA + (size_t)(t + 1) * kstep;
            const char* a2 = last ? nA : cA + (size_t)(t + 2) * kstep; const char* b2 = last ? nB : cB + (size_t)(t + 2) * kstep;
            const char* a3 = a2 + kstep; const char* b3 = b2 + kstep;
            if (last && has_next) S.a_ready(nxt);
            if constexpr (SP2) {
            PG8_LDB(B0, 0, 0); PG8_LDB(B1, 0, 1); PG8_SCHED; PG8_LDA(At, 0, 0); PG8_STAGE(PG8_SA(1, 1), a1 + hstep, voffA);
            PG8_WAIT_V(8); PG8_WAIT_L(0); PG8_BAR; PG8_MMA(0, 0, At, B0); PG8_MMA(0, 1, At, B1); PG8_BAR; PG8_SCHED;
            PG8_LDA(At, 0, 1); PG8_STAGE(PG8_SB(0, 0), b2, voffB); PG8_STAGE(PG8_SB(0, 1), b2 + hstep, voffB); PG8_STAGE(PG8_SA(0, 0), a2, voffA);
            PG8_WAIT_V(8); PG8_WAIT_L(0); PG8_BAR; PG8_MMA(1, 0, At, B0); PG8_MMA(1, 1, At, B1); PG8_BAR; PG8_SCHED;
            PG8_LDB(B0, 1, 0); PG8_LDB(B1, 1, 1); PG8_SCHED; PG8_LDA(At, 1, 0); PG8_STAGE(PG8_SA(0, 1), a2 + hstep, voffA);
            PG8_WAIT_V(8); PG8_WAIT_L(0); PG8_BAR; PG8_MMA(0, 0, At, B0); PG8_MMA(0, 1, At, B1); PG8_BAR; PG8_SCHED;
            PG8_LDA(At, 1, 1); PG8_STAGE(PG8_SB(1, 0), b3, voffB); PG8_STAGE(PG8_SB(1, 1), b3 + hstep, voffB); PG8_STAGE(PG8_SA(1, 0), a3, voffA);
            PG8_WAIT_V(8); PG8_WAIT_L(0); PG8_BAR; PG8_MMA(1, 0, At, B0); PG8_MMA(1, 1, At, B1); PG8_BAR; PG8_SCHED;
            } else {
            PG8_LDB(B0, 0, 0); PG8_SCHED; PG8_LDA(At, 0, 0); PG8_STAGE(PG8_SA(1, 1), a1 + hstep, voffA);
            PG8_WAIT_L(8); PG8_BAR; PG8_WAIT_L(0); PG8_MMA(0, 0, At, B0); PG8_BAR; PG8_SCHED;
            PG8_LDB(B1, 0, 1); PG8_STAGE(PG8_SB(0, 0), b2, voffB);
            PG8_BAR; PG8_WAIT_L(0); PG8_MMA(0, 1, At, B1); PG8_BAR;
            PG8_LDA(At, 0, 1); PG8_STAGE(PG8_SA(0, 0), a2, voffA);
            PG8_BAR; PG8_WAIT_L(0); PG8_MMA(1, 0, At, B0); PG8_BAR; PG8_SCHED;
            PG8_STAGE(PG8_SB(0, 1), b2 + hstep, voffB);
            PG8_WAIT_V(6); PG8_BAR; PG8_MMA(1, 1, At, B1); PG8_BAR;
            PG8_LDB(B0, 1, 0); PG8_SCHED; PG8_LDA(At, 1, 0); PG8_STAGE(PG8_SA(0, 1), a2 + hstep, voffA);
            PG8_WAIT_L(8); PG8_BAR; PG8_WAIT_L(0); PG8_MMA(0, 0, At, B0); PG8_BAR; PG8_SCHED;
            PG8_LDB(B1, 1, 1); PG8_STAGE(PG8_SB(1, 0), b3, voffB);
            PG8_BAR; PG8_WAIT_L(0); PG8_MMA(0, 1, At, B1); PG8_BAR;
            PG8_LDA(At, 1, 1); PG8_STAGE(PG8_SA(1, 0), a3, voffA);
            PG8_BAR; PG8_WAIT_L(0); PG8_MMA(1, 0, At, B0); PG8_BAR; PG8_SCHED;
            PG8_STAGE(PG8_SB(1, 1), b3 + hstep, voffB);
            PG8_WAIT_V(6); PG8_BAR; PG8_MMA(1, 1, At, B1); PG8_BAR;
            }
        }
        if constexpr (ALIGN_EPI) { if (wr == 0) PG8_BAR; }
        if constexpr (!Epi::AFTER_DRAIN) { E(acc, cur, wr, wc, fr, fq); S.done(cur); }
        if (!has_next) break;
#pragma unroll
        for (int a = 0; a < 2; ++a)
#pragma unroll
            for (int b = 0; b < 2; ++b)
#pragma unroll
                for (int m = 0; m < 4; ++m)
#pragma unroll
                    for (int n = 0; n < 2; ++n) acc[a][b][m][n] = (f32x4){0.f, 0.f, 0.f, 0.f};
        cur = nxt; cA = nA; cB = nB; ++ui;
        if constexpr (ALIGN_EPI) { if (wr == 1) PG8_BAR; }
    }
    PG8_WAIT_V(0);
    if constexpr (!ALIGN_EPI) { if (wr == 0) PG8_BAR; }
    PG8_BAR;
    if constexpr (Epi::AFTER_DRAIN) { E.fused(acc, cur, wr, wc, fr, fq, lds, wid, lane); S.done(cur); }
#undef PG8_SA
#undef PG8_SB
#undef PG8_STAGE
#undef PG8_LDA
#undef PG8_LDB
#undef PG8_MMA
#undef PG8_WAIT_V
#undef PG8_WAIT_L
#undef PG8_BAR
#undef PG8_SCHED
}
}

#ifndef DUPMASK
#define DUPMASK 0
#endif
#define DUP(k) for (int rep_ = 0; rep_ < 1 + ((DUPMASK >> (k)) & 1); ++rep_)
#ifndef PHMASK
#define PHMASK 0x3fff
#endif
namespace {
typedef unsigned short bf16;
typedef float f32x4 __attribute__((ext_vector_type(4)));
typedef unsigned u32x4 __attribute__((ext_vector_type(4)));
typedef unsigned u32x2 __attribute__((ext_vector_type(2)));
typedef short bf16x8 __attribute__((ext_vector_type(8)));
typedef short bf16x4 __attribute__((ext_vector_type(4)));

constexpr int D = 2048, SEQ = 8192, NS = 128, MT = 8320, MP = 8448;
constexpr int F = 5632;
constexpr int RCOLS = 3360, QOFF = 3360, KVOFF = 4384, GNOFF = 5920, GMOFF = 5968, INC = 10064;
constexpr int UAW = 3584;
constexpr int NIN = 10240;
constexpr int PAST = 8192;
constexpr float ALPHA = 1.189207115002721f;
constexpr float NEG = -3.0e38f;
constexpr float QSCALE = 0.125f * 1.4426950408889634f;
constexpr int NTHR = 512;
constexpr int LDS_RING = 131072;
constexpr int LDS_BYTES = 147456;

struct Params {
    const float *x_p, *x_s, *cache_cmp, *cache_sel; const int* pt; const float *state_win, *state_rwkv, *state_shift;
    const float *ln1_g, *ln1_b, *w_gu1, *w_dn1, *w_in, *mu, *w0, *w2, *a0, *a2, *g2, *k_k, *k_a, *r_k, *rln_w, *rln_b, *w_up_a;
    const float *cmp_pe, *cmp_wa, *cmp_wb, *w_up_b, *w_o, *ln2_g, *ln2_b, *w_gu2, *w_dn2, *ln3_g, *ln3_b;
    float *o_y_p, *o_y_s, *o_cmp_p, *o_sel_p, *o_win_p, *o_state_p, *o_shift_p, *o_cmp_s, *o_sel_s, *o_win_s, *o_state_s, *o_shift_s;
    unsigned* bar;
    bf16 *XAb, *ACTb, *H1b, *H2b, *Qb, *Kc, *Vc, *GMb, *ROb, *Ob, *MIXb;
    bf16 *Vtb, *KCb, *VCtb;
    unsigned* ctl;
    bf16 *Wgu1t, *Wdn1t, *Wint, *Wupat, *Wupbt, *Wot, *Wgu2t, *Wdn2t, *Lw2t, *La2t, *Lg2t;
    float *PRE, *LNST, *UA, *MIXA, *SLAB;
    float *SC, *YS, *C12, *G;
    float *KCVs;
#ifdef NSA_CHECK
    float *KCVp, *Ob2;
#endif
};

__device__ __forceinline__ float sigm(float x) { return 1.f / (1.f + __expf(-x)); }
__device__ __forceinline__ float wave_sum(float v) { for (int o = 32; o >= 1; o >>= 1) v += __shfl_xor(v, o); return v; }
__device__ __forceinline__ float wave_max(float v) { for (int o = 32; o >= 1; o >>= 1) v = fmaxf(v, __shfl_xor(v, o)); return v; }
__device__ __forceinline__ float bf_lo(unsigned w) { return __uint_as_float(w << 16); }
__device__ __forceinline__ float bf_hi(unsigned w) { return __uint_as_float(w & 0xffff0000u); }
using pg8::cvt_pk_bf16;

struct PieceOrder : pg8::StaticOrder {
    int npieces, ppt, pkt;
    __device__ bool next(int i, pg8::Unit& u) const {
        if (i == 0) return pg8::StaticOrder::next(0, u);
        if (i == 1 && c < npieces) { u.pm = 32; u.pn = c / ppt; u.kt0 = (c % ppt) * pkt; u.nkt = pkt; return true; }
        return false;
    }
};
struct EpiSwiglu {
    static constexpr bool PERM = true, AFTER_DRAIN = false;
    bf16* O;
    __device__ __forceinline__ void operator()(const f32x4 (&acc)[2][2][4][2], const pg8::Unit& u, int wr, int wc, int fr, int fq) const {
        const int row0 = u.pm * 256 + wr * 64 + fr, col0 = u.pn * 128 + wc * 32 + 8 * fq;
#pragma unroll
        for (int ai = 0; ai < 2; ++ai)
#pragma unroll
            for (int m = 0; m < 4; ++m) {
                float v[8];
#pragma unroll
                for (int n = 0; n < 2; ++n)
#pragma unroll
                    for (int j = 0; j < 4; ++j) { const float g = acc[ai][0][m][n][j], up = acc[ai][1][m][n][j]; v[n * 4 + j] = g * up * __builtin_amdgcn_rcpf(1.f + __expf(-g)); }
                u32x4 w; w.x = cvt_pk_bf16(v[0], v[1]); w.y = cvt_pk_bf16(v[2], v[3]); w.z = cvt_pk_bf16(v[4], v[5]); w.w = cvt_pk_bf16(v[6], v[7]);
                *(u32x4*)(O + (size_t)(row0 + ai * 128 + m * 16) * F + col0) = w;
            }
    }
};
struct EpiResid {
    static constexpr bool PERM = false, AFTER_DRAIN = false;
    float* O; const float* r0; const float* r1; float s; float* SL; int ppt; const float* st; const float* lg; const float* lb;
    __device__ __forceinline__ void operator()(const f32x4 (&acc)[2][2][4][2], const pg8::Unit& u, int wr, int wc, int fr, int fq) const {
        const int col0 = u.pn * 256 + wc * 32 + 4 * fq;
        if (u.nkt) {
            float* sl = SL + ((size_t)(u.pn * ppt + u.kt0 / u.nkt) * 128 + wr * 64 + fr) * 256 + wc * 32 + 4 * fq;
#pragma unroll
            for (int m = 0; m < 4; ++m)
#pragma unroll
                for (int bj = 0; bj < 2; ++bj)
#pragma unroll
                    for (int n = 0; n < 2; ++n) *(f32x4*)(sl + m * 16 * 256 + bj * 128 + n * 16) = acc[0][bj][m][n] * s;
            return;
        }
#pragma unroll
        for (int ai = 0; ai < 2; ++ai) {
            if (!(u.pm == 32 && ai == 1))
#pragma unroll
            for (int m = 0; m < 4; ++m) {
                const int row = u.pm * 256 + ai * 128 + wr * 64 + m * 16 + fr;
                const float* rp = (u.pm < 32) ? r0 + (size_t)row * D : r1 + (size_t)(row - SEQ) * D;
                float* op = O + (size_t)row * D;
#pragma unroll
                for (int bj = 0; bj < 2; ++bj)
#pragma unroll
                    for (int n = 0; n < 2; ++n) { const int c = col0 + bj * 128 + n * 16;
                        f32x4 rv;
                        if (st) { const float mean = st[2 * row], rstd = st[2 * row + 1]; rv = (*(const f32x4*)(op + c) - mean) * rstd * *(const f32x4*)(lg + c) + *(const f32x4*)(lb + c); }
                        else rv = *(const f32x4*)(rp + c);
                        *(f32x4*)(op + c) = rv * ALPHA + acc[ai][bj][m][n] * s; }
            }
        }
    }
};
struct EpiWin {
    static constexpr bool PERM = true, AFTER_DRAIN = false;
    float* UA; bf16* Qb; bf16* Kc; bf16* Vc; bf16* GMb;
    float *o_cmp_p, *o_sel_p, *o_win_p, *o_shift_p, *o_cmp_s, *o_sel_s, *o_win_s, *o_shift_s;
    __device__ __forceinline__ void operator()(const f32x4 (&acc)[2][2][4][2], const pg8::Unit& u, int wr, int wc, int fr, int fq) const {
#pragma unroll
        for (int ai = 0; ai < 2; ++ai) {
            if (!(u.pm == 32 && ai == 1))
#pragma unroll
            for (int m = 0; m < 4; ++m) {
                const int row = u.pm * 256 + ai * 128 + wr * 64 + m * 16 + fr;
#pragma unroll
                for (int bj = 0; bj < 2; ++bj) {
                    const int v = u.pn * 256 + bj * 128 + wc * 32 + 8 * fq;
                    const f32x4 a0 = acc[ai][bj][m][0], a1 = acc[ai][bj][m][1];
                    if (u.pn < 14) {
                        float* dst = UA + (size_t)row * UAW + v; *(f32x4*)dst = a0; *(f32x4*)(dst + 4) = a1;
                        if (v < RCOLS) {
                            if (row == SEQ - 1) { *(f32x4*)(o_shift_p + v) = a0; *(f32x4*)(o_shift_p + v + 4) = a1; }
                            if (row >= SEQ && ((row - SEQ) & 3) == 3) { float* d2 = o_shift_s + (size_t)((row - SEQ) >> 2) * RCOLS + v; *(f32x4*)d2 = a0; *(f32x4*)(d2 + 4) = a1; }
                        }
                    } else if (u.pn < 18) {
                        u32x4 w; w.x = cvt_pk_bf16(a0[0] * QSCALE, a0[1] * QSCALE); w.y = cvt_pk_bf16(a0[2] * QSCALE, a0[3] * QSCALE); w.z = cvt_pk_bf16(a1[0] * QSCALE, a1[1] * QSCALE); w.w = cvt_pk_bf16(a1[2] * QSCALE, a1[3] * QSCALE);
                        *(u32x4*)(Qb + (size_t)row * 1024 + (v - 3584)) = w;
                    } else if (u.pn < 24) {
                        const int kc = v - 4608, br = kc >> 9, wi = kc & 511;
                        u32x4 w; w.x = cvt_pk_bf16(a0[0], a0[1]); w.y = cvt_pk_bf16(a0[2], a0[3]); w.z = cvt_pk_bf16(a1[0], a1[1]); w.w = cvt_pk_bf16(a1[2], a1[3]);
                        { const int kvh_ = (kc >> 6) & 3, d8 = kc & 63;
                          if ((kc >> 8) & 1) *(u32x4*)(Vc + ((size_t)(br * 4 + kvh_) * MP + row) * 64 + d8) = w;
                          else *(u32x4*)(Kc + (size_t)(br * 4 + kvh_) * MP * 64 + (size_t)(row >> 4) * 1024 + (d8 >> 5) * 512 + ((d8 >> 3) & 3) * 128 + (row & 15) * 8) = w; }
                        float* dst = nullptr;
                        if (row < SEQ) { if (br == 0) dst = o_cmp_p + (size_t)row * 512 + wi; else if (br == 1) dst = o_sel_p + (size_t)row * 512 + wi; else if (row >= SEQ - 512) dst = o_win_p + (size_t)(row - (SEQ - 512)) * 512 + wi; }
                        else { const int s = row - SEQ; if (br == 0) dst = o_cmp_s + (size_t)s * 512 + wi; else if (br == 1) dst = o_sel_s + (size_t)s * 512 + wi; else dst = o_win_s + ((size_t)(s >> 2) * 512 + 508 + (s & 3)) * 512 + wi; }
                        if (dst) { *(f32x4*)dst = a0; *(f32x4*)(dst + 4) = a1; }
                    } else {
                        u32x4 w; w.x = cvt_pk_bf16(sigm(a0[0]), sigm(a0[1])); w.y = cvt_pk_bf16(sigm(a0[2]), sigm(a0[3])); w.z = cvt_pk_bf16(sigm(a1[0]), sigm(a1[1])); w.w = cvt_pk_bf16(sigm(a1[2]), sigm(a1[3]));
                        *(u32x4*)(GMb + (size_t)row * 4096 + (v - 6144)) = w;
                    }
                }
            }
        }
    }
};
template <bool SECOND> struct EpiUp {
    static constexpr bool PERM = true, AFTER_DRAIN = false;
    float* MIXA; bf16* MIXb; const bf16* GM; float* SL; int which;
    __device__ __forceinline__ void operator()(const f32x4 (&acc)[2][2][4][2], const pg8::Unit& u, int wr, int wc, int fr, int fq) const {
        if (u.nkt) {
            float* sl = SL + ((size_t)((which * 8 + u.pn) * 4 + u.kt0 / u.nkt) * 128 + wr * 64 + fr) * 256 + wc * 32 + 8 * fq;
#pragma unroll
            for (int m = 0; m < 4; ++m)
#pragma unroll
                for (int bj = 0; bj < 2; ++bj) {
                    const u32x4 g = *(const u32x4*)(GM + (size_t)(SEQ + wr * 64 + m * 16 + fr) * 4096 + u.pn * 256 + bj * 128 + wc * 32 + 8 * fq);
                    f32x4 a0 = acc[0][bj][m][0], a1 = acc[0][bj][m][1];
                    a0[0] *= bf_lo(g.x); a0[1] *= bf_hi(g.x); a0[2] *= bf_lo(g.y); a0[3] *= bf_hi(g.y);
                    a1[0] *= bf_lo(g.z); a1[1] *= bf_hi(g.z); a1[2] *= bf_lo(g.w); a1[3] *= bf_hi(g.w);
                    *(f32x4*)(sl + m * 16 * 256 + bj * 128) = a0; *(f32x4*)(sl + m * 16 * 256 + bj * 128 + 4) = a1;
                }
            return;
        }
#pragma unroll
        for (int ai = 0; ai < 2; ++ai)
#pragma unroll
            for (int m = 0; m < 4; ++m) {
                const int row = u.pm * 256 + ai * 128 + wr * 64 + m * 16 + fr;
#pragma unroll
                for (int bj = 0; bj < 2; ++bj) {
                    const int c = u.pn * 256 + bj * 128 + wc * 32 + 8 * fq;
                    const u32x4 g = *(const u32x4*)(GM + (size_t)row * 4096 + c);
                    f32x4 a0 = acc[ai][bj][m][0], a1 = acc[ai][bj][m][1];
                    a0[0] *= bf_lo(g.x); a0[1] *= bf_hi(g.x); a0[2] *= bf_lo(g.y); a0[3] *= bf_hi(g.y);
                    a1[0] *= bf_lo(g.z); a1[1] *= bf_hi(g.z); a1[2] *= bf_lo(g.w); a1[3] *= bf_hi(g.w);
                    float* mp = MIXA + (size_t)row * D + c;
                    if (!SECOND) { *(f32x4*)mp = a0; *(f32x4*)(mp + 4) = a1; }
                    else {
                        a0 += *(const f32x4*)mp; a1 += *(const f32x4*)(mp + 4);
                        u32x4 w; w.x = cvt_pk_bf16(a0[0], a0[1]); w.y = cvt_pk_bf16(a0[2], a0[3]); w.z = cvt_pk_bf16(a1[0], a1[1]); w.w = cvt_pk_bf16(a1[2], a1[3]);
                        *(u32x4*)(MIXb + (size_t)row * D + c) = w;
                    }
                }
            }
    }
};

__device__ __forceinline__ int src_col_gu(int n) { const int pn = n >> 8, w = n & 255; return w < 128 ? pn * 128 + w : F + pn * 128 + (w - 128); }
__device__ __forceinline__ int src_col_in(int v) { if (v < 3360) return v; if (v < 3408) return GNOFF + (v - 3360); if (v < 3584) return -1; if (v < 4608) return QOFF + (v - 3584); if (v < 6144) return KVOFF + (v - 4608); return GMOFF + (v - 6144); }
template <int MAP>
__device__ __forceinline__ void transpose_w(const float* __restrict__ W, int K, int ldw, bf16* __restrict__ Wt, int NP, LAS float* scr, int tid, int wg, int nwg) {
    const int ntk = K >> 6, nitems = (NP >> 6) * ntk;
    for (int item = wg; item < nitems; item += nwg) {
        const int n0 = (item / ntk) << 6, k0 = (item % ntk) << 6;
        { const int k = tid >> 3, nc = (tid & 7) * 8, nn = n0 + nc;
          const int sc = MAP == 0 ? nn : (MAP == 1 ? src_col_gu(nn) : (MAP == 3 ? src_col_gu(nn + F) : src_col_in(nn)));
          float4 a = make_float4(0.f, 0.f, 0.f, 0.f), b = a;
          if (sc >= 0) { const float* s = W + (size_t)(k0 + k) * ldw + sc; a = *(const float4*)s; b = *(const float4*)(s + 4); }
          LAS float* d = scr + k * 65 + nc;
          d[0] = a.x; d[1] = a.y; d[2] = a.z; d[3] = a.w; d[4] = b.x; d[5] = b.y; d[6] = b.z; d[7] = b.w; }
        __syncthreads();
        { const int n = tid >> 3, kc = (tid & 7) * 8; const LAS float* s = scr + kc * 65 + n;
          u32x4 w; w.x = cvt_pk_bf16(s[0], s[65]); w.y = cvt_pk_bf16(s[130], s[195]); w.z = cvt_pk_bf16(s[260], s[325]); w.w = cvt_pk_bf16(s[390], s[455]);
          *(u32x4*)(Wt + (size_t)(n0 + n) * K + k0 + kc) = w; }
        __syncthreads();
    }
}

template <bool FINAL>
__device__ __forceinline__ void ln_rows(float* PRE, const float* __restrict__ g, const float* __restrict__ b, float* Hf, bf16* Hb, float* outp, float* outs, const float* SL, int ppt, int gw, int nw, int lane, int wid, LAS float* red) {
    if (blockIdx.x < NS) {
        const int sr = (int)blockIdx.x, row = SEQ + sr, c = wid * 256 + lane * 4;
        f32x4 v = *(const f32x4*)(PRE + (size_t)row * D + c);
        for (int pc = 0; pc < ppt; ++pc) v += *(const f32x4*)(SL + ((size_t)(wid * ppt + pc) * 128 + sr) * 256 + lane * 4);
        const float s = wave_sum((v[0] + v[1]) + (v[2] + v[3]));
        if (lane == 0) red[wid] = s;
        __syncthreads();
        const float mean = ((red[0] + red[1]) + (red[2] + red[3]) + (red[4] + red[5]) + (red[6] + red[7])) * (1.f / D);
        v -= mean;
        const float q = wave_sum((v[0] * v[0] + v[1] * v[1]) + (v[2] * v[2] + v[3] * v[3]));
        if (lane == 0) red[8 + wid] = q;
        __syncthreads();
        const float rs = rsqrtf(((red[8] + red[9]) + (red[10] + red[11]) + (red[12] + red[13]) + (red[14] + red[15])) * (1.f / D) + 1e-5f);
        const f32x4 o = v * rs * *(const f32x4*)(g + c) + *(const f32x4*)(b + c);
        if (FINAL) *(f32x4*)(outs + (size_t)sr * D + c) = o;
        else { *(f32x4*)(PRE + (size_t)row * D + c) = o * ALPHA;
               u32x2 w; w.x = cvt_pk_bf16(o[0], o[1]); w.y = cvt_pk_bf16(o[2], o[3]); *(u32x2*)(Hb + (size_t)row * D + c) = w; }
    }
    for (int row = gw; row < SEQ; row += nw) {
        const float* x = PRE + (size_t)row * D;
        f32x4 v[8]; float s = 0.f;
#pragma unroll
        for (int i = 0; i < 8; ++i) v[i] = *(const f32x4*)(x + (i * 64 + lane) * 4);
#pragma unroll
        for (int i = 0; i < 8; ++i) s += (v[i][0] + v[i][1]) + (v[i][2] + v[i][3]);
        const float mean = wave_sum(s) * (1.f / D);
        float q = 0.f;
#pragma unroll
        for (int i = 0; i < 8; ++i) { v[i] -= mean; q += (v[i][0] * v[i][0] + v[i][1] * v[i][1]) + (v[i][2] * v[i][2] + v[i][3] * v[i][3]); }
        const float rs = rsqrtf(wave_sum(q) * (1.f / D) + 1e-5f);
        if (!FINAL && lane == 0) { Hf[2 * row] = mean; Hf[2 * row + 1] = rs; }
#pragma unroll
        for (int i = 0; i < 8; ++i) {
            const int c = (i * 64 + lane) * 4;
            const f32x4 o = v[i] * rs * *(const f32x4*)(g + c) + *(const f32x4*)(b + c);
            if (FINAL) *(f32x4*)(outp + (size_t)row * D + c) = o;
            else { u32x2 w; w.x = cvt_pk_bf16(o[0], o[1]); w.y = cvt_pk_bf16(o[2], o[3]); *(u32x2*)(Hb + (size_t)row * D + c) = w; }
        }
    }
}

constexpr int SCH = 6 * 64, SCR = 16 * SCH;
__device__ __forceinline__ float tshift(const Params& p, int row, int col) {
    const bool samp = row >= SEQ; const int t = samp ? ((row - SEQ) & 3) : row;
    const float x = p.UA[(size_t)row * UAW + col];
    const float pv = (t > 0) ? p.UA[(size_t)(row - 1) * UAW + col] : (samp ? p.state_shift[(size_t)((row - SEQ) >> 2) * RCOLS + col] : 0.f);
    return x + (pv - x) * p.mu[col];
}
__device__ __forceinline__ f32x4 tshift4(const Params& p, int row, int col) {
    const bool samp = row >= SEQ; const int t = samp ? ((row - SEQ) & 3) : row;
    const f32x4 x = *(const f32x4*)(p.UA + (size_t)row * UAW + col);
    f32x4 pv = {0.f, 0.f, 0.f, 0.f};
    if (t > 0) pv = *(const f32x4*)(p.UA + (size_t)(row - 1) * UAW + col);
    else if (samp) pv = *(const f32x4*)(p.state_shift + (size_t)((row - SEQ) >> 2) * RCOLS + col);
    return x + (pv - x) * *(const f32x4*)(p.mu + col);
}
template <int CTRL> __device__ __forceinline__ float dpp_mov(float x) { return __builtin_bit_cast(float, __builtin_amdgcn_update_dpp(0, __builtin_bit_cast(int, x), CTRL, 0xf, 0xf, false)); }
__device__ __forceinline__ float row_sum16(float x) { x += dpp_mov<0x128>(x); x += dpp_mov<0x124>(x); x += dpp_mov<0x122>(x); x += dpp_mov<0x121>(x); return x; }
__device__ __forceinline__ float half_sum32(float x) { x = row_sum16(x); return x + __shfl_xor(x, 16); }
typedef float f32x16p __attribute__((ext_vector_type(16)));
constexpr int PA_LD = 296;
__device__ __forceinline__ void rwkv_prep_phase(const Params& p, LAS unsigned char* ldsb, int tid) {
    LAS bf16* Ai = (LAS bf16*)ldsb;
    const int lane = tid & 63, w = tid >> 6, l31 = lane & 31, kh = lane >> 5;
    LAS float* stS = (LAS float*)(ldsb + 20480) + w * 3072;
    for (int pass = 0; pass < 2; ++pass) {
        if (pass == 1 && blockIdx.x >= 64) break;
        const int tile = pass == 0 ? (int)blockIdx.x : 256 + ((int)blockIdx.x >> 4);
        const int hbeg = pass == 0 ? 2 * w : ((int)blockIdx.x & 15), nhd = pass == 0 ? 2 : (w == 0 ? 1 : 0);
        const int row0 = tile * 32;
#pragma unroll 6
        for (int it = 0; it < 18; ++it) {
            const int e = tid + it * NTHR, r = e / 288, c = e - r * 288;
            const float u = tshift(p, row0 + r, 3072 + c);
            const float th = 1.f - 2.f * __builtin_amdgcn_rcpf(__expf(2.f * u) + 1.f);
            Ai[r * PA_LD + c] = (bf16)(cvt_pk_bf16(c < 64 ? th : (c < 128 ? u : sigm(u)), 0.f) & 0xffffu);
        }
        __syncthreads();
#pragma unroll 1
        for (int hh = 0; hh < nhd; ++hh) {
            const int hd = hbeg + hh;
            f32x16p zw[2], za[2], zg[2];
#pragma unroll
            for (int t = 0; t < 2; ++t) {
                const int ch = hd * 64 + t * 32 + l31;
                const f32x16p iw = {0.f,0.f,0.f,0.f,0.f,0.f,0.f,0.f,0.f,0.f,0.f,0.f,0.f,0.f,0.f,0.f};
                zw[t] = iw; za[t] = iw; zg[t] = iw;
                const LAS bf16* ap = Ai + l31 * PA_LD + 8 * kh;
                const bf16* bw = p.Lw2t + (size_t)ch * 64 + 8 * kh; const bf16* ba = p.La2t + (size_t)ch * 64 + 8 * kh; const bf16* bg = p.Lg2t + (size_t)ch * 160 + 8 * kh;
#pragma unroll
                for (int ks = 0; ks < 4; ++ks) {
                    zw[t] = __builtin_amdgcn_mfma_f32_32x32x16_bf16(*(const LAS bf16x8*)(ap + ks * 16), *(const bf16x8*)(bw + ks * 16), zw[t], 0, 0, 0);
                    za[t] = __builtin_amdgcn_mfma_f32_32x32x16_bf16(*(const LAS bf16x8*)(ap + 64 + ks * 16), *(const bf16x8*)(ba + ks * 16), za[t], 0, 0, 0);
                }
#pragma unroll
                for (int ks = 0; ks < 10; ++ks) zg[t] = __builtin_amdgcn_mfma_f32_32x32x16_bf16(*(const LAS bf16x8*)(ap + 128 + ks * 16), *(const bf16x8*)(bg + ks * 16), zg[t], 0, 0, 0);
            }
            float w0c[2], a0c[2], kkw[2], kaw[2], rkw[2], mur[2], muk[2], muv[2];
#pragma unroll
            for (int t = 0; t < 2; ++t) { const int ch = hd * 64 + t * 32 + l31; w0c[t] = p.w0[ch]; a0c[t] = p.a0[ch]; kkw[t] = p.k_k[ch]; kaw[t] = p.k_a[ch]; rkw[t] = p.r_k[ch];
                mur[t] = p.mu[ch]; muk[t] = p.mu[1024 + ch]; muv[t] = p.mu[2048 + ch]; }
#pragma unroll
            for (int r = 0; r < 16; ++r) {
                int row_ = row0 + (r & 3) + 8 * (r >> 2) + 4 * kh; asm volatile("" : "+v"(row_));
                const int row = row_;
                const bool samp = row >= SEQ; const int tt = samp ? ((row - SEQ) & 3) : row;
                const float* ux = p.UA + (size_t)row * UAW;
                const float* up = (tt > 0) ? ux - UAW : (samp ? p.state_shift + (size_t)((row - SEQ) >> 2) * RCOLS : nullptr);
                float rr[2], kx[2], vx[2], ss = 0.f;
#pragma unroll
                for (int t = 0; t < 2; ++t) { const int ch = hd * 64 + t * 32 + l31;
                    const float xr = ux[ch], xk = ux[1024 + ch], xv = ux[2048 + ch];
                    const float pr = up ? up[ch] : 0.f, pk = up ? up[1024 + ch] : 0.f, pv = up ? up[2048 + ch] : 0.f;
                    rr[t] = xr + (pr - xr) * mur[t]; kx[t] = xk + (pk - xk) * muk[t]; vx[t] = xv + (pv - xv) * muv[t];
                    const float kk = kx[t] * kkw[t]; ss += kk * kk; }
                ss = half_sum32(ss);
                const float inv = 1.f / fmaxf(sqrtf(ss), 1e-12f);
                float c1 = 0.f, c2 = 0.f, bon = 0.f;
#pragma unroll
                for (int t = 0; t < 2; ++t) {
                    const float z = -(zw[t][r] + w0c[t]);
                    const float sp = fmaxf(z, 0.f) + __logf(1.f + __expf(-fabsf(z)));
                    const float dec = __expf(-__expf(-sp - 0.5f));
                    const float av = __builtin_amdgcn_rcpf(1.f + __expf(-(za[t][r] + a0c[t])));
                    const float kk = kx[t] * kkw[t] * inv, kt = kx[t] * (1.f + (av - 1.f) * kaw[t]), bb = kk * av;
                    c1 += bb * rr[t]; c2 += kt * rr[t]; bon += rr[t] * kt * rkw[t];
                    LAS float* q = stS + (((r & 3) + 4 * kh) * 6) * 64 + t * 32 + l31;
                    q[0] = kk; q[64] = dec * rr[t]; q[128] = dec; q[192] = bb; q[256] = kt; q[320] = vx[t];
                    p.G[(size_t)row * 1024 + hd * 64 + t * 32 + l31] = zg[t][r];
                }
                c1 = half_sum32(c1); c2 = half_sum32(c2); bon = half_sum32(bon);
                if (l31 == 0) *(f32x4*)(p.C12 + ((size_t)row * 16 + hd) * 4) = (f32x4){c1, c2, bon, 0.f};
                if ((r & 3) == 3) {
                    const int rbase = row0 + 8 * (r >> 2);
#pragma unroll 2
                    for (int rs = 0; rs < 8; ++rs) {
                        float* dst = p.SC + (size_t)(rbase + rs) * SCR + hd * SCH; const LAS float* src = stS + rs * 384;
                        *(f32x4*)(dst + lane * 4) = *(const LAS f32x4*)(src + lane * 4);
                        if (lane < 32) *(f32x4*)(dst + 256 + lane * 4) = *(const LAS f32x4*)(src + 256 + lane * 4);
                    }
                    __builtin_amdgcn_sched_barrier(0);
                }
            }
        }
        __syncthreads();
    }
}


struct ScanGrp { f32x4 kk, wr, ww, bb, kt; float v; };
__device__ __forceinline__ void scan_load(ScanGrp& x, const float* __restrict__ sc, int g, int r4, int kq, int rowv) {
    const float* q = sc + (size_t)(4 * g + r4) * SCR + 4 * kq;
    x.kk = *(const f32x4*)(q); x.wr = *(const f32x4*)(q + 64); x.ww = *(const f32x4*)(q + 128); x.bb = *(const f32x4*)(q + 192); x.kt = *(const f32x4*)(q + 256);
    x.v = sc[(size_t)(4 * g + (kq & 3)) * SCR + 320 + rowv];
}
__device__ __forceinline__ void scan_stage(const ScanGrp& x, LAS float* stg, float (&vj)[4], int r4, int kq) {
    LAS float* w = stg + r4 * 320 + 4 * kq;
    *(LAS f32x4*)(w) = x.kk; *(LAS f32x4*)(w + 64) = x.wr; *(LAS f32x4*)(w + 128) = x.ww; *(LAS f32x4*)(w + 192) = x.bb; *(LAS f32x4*)(w + 256) = x.kt;
    vj[0] = dpp_mov<0x00>(x.v); vj[1] = dpp_mov<0x55>(x.v); vj[2] = dpp_mov<0xAA>(x.v); vj[3] = dpp_mov<0xFF>(x.v);
}
__device__ __forceinline__ void scan_steps(const float (&vj)[4], LAS float* stg, float& S0, float& S1, float& S2, float& S3, float* __restrict__ ys, int r4, int kq) {
    float sa4[4], py4[4];
    const LAS float* r0 = stg + 4 * kq;
    f32x4 k4 = *(const LAS f32x4*)(r0), r4v = *(const LAS f32x4*)(r0 + 64), w4 = *(const LAS f32x4*)(r0 + 128), b4 = *(const LAS f32x4*)(r0 + 192), t4 = *(const LAS f32x4*)(r0 + 256);
#pragma unroll
    for (int j = 0; j < 4; ++j) {
        f32x4 nk = k4, nr = r4v, nw = w4, nb = b4, nt = t4;
        if (j < 3) { const LAS float* r = stg + (j + 1) * 320 + 4 * kq;
            nk = *(const LAS f32x4*)(r); nr = *(const LAS f32x4*)(r + 64); nw = *(const LAS f32x4*)(r + 128); nb = *(const LAS f32x4*)(r + 192); nt = *(const LAS f32x4*)(r + 256); }
        __builtin_amdgcn_sched_barrier(0);
        const f32x4 vk = t4 * vj[j];
        float psa = S0 * k4[0] + S1 * k4[1] + S2 * k4[2] + S3 * k4[3];
        py4[j] = S0 * r4v[0] + S1 * r4v[1] + S2 * r4v[2] + S3 * r4v[3];
        S0 = fmaf(S0, w4[0], vk[0]); S1 = fmaf(S1, w4[1], vk[1]); S2 = fmaf(S2, w4[2], vk[2]); S3 = fmaf(S3, w4[3], vk[3]);
        psa = row_sum16(psa); sa4[j] = psa;
        S0 = fmaf(-psa, b4[0], S0); S1 = fmaf(-psa, b4[1], S1); S2 = fmaf(-psa, b4[2], S2); S3 = fmaf(-psa, b4[3], S3);
        k4 = nk; r4v = nr; w4 = nw; b4 = nb; t4 = nt;
    }
    const bool hi8 = (kq & 8) != 0, hi4 = (kq & 4) != 0;
    float a = hi8 ? py4[2] : py4[0], b = hi8 ? py4[3] : py4[1];
    const float sa_ = hi8 ? py4[0] : py4[2], sb_ = hi8 ? py4[1] : py4[3];
    a += dpp_mov<0x128>(sa_); b += dpp_mov<0x128>(sb_);
    float c = hi4 ? b : a; const float sc_ = hi4 ? a : b;
    c += dpp_mov<0x141>(sc_);
    c += dpp_mov<0xB1>(c); c += dpp_mov<0x4E>(c);
    const float osa = hi8 ? (hi4 ? sa4[3] : sa4[2]) : (hi4 ? sa4[1] : sa4[0]);
    if ((kq & 3) == 0) { float2 o; o.x = osa; o.y = c; *(float2*)(ys + (size_t)(2 * (kq >> 3) + ((kq >> 2) & 1)) * 2048) = o; }
}
__device__ __forceinline__ void scan_group(const ScanGrp& x, LAS float* stg, float& S0, float& S1, float& S2, float& S3, float* __restrict__ ys, int r4, int kq) {
    float vj[4]; scan_stage(x, stg, vj, r4, kq); scan_steps(vj, stg, S0, S1, S2, S3, ys, r4, kq);
}
template <bool SAMPLE>
__device__ __forceinline__ void rwkv_scan_fast(const Params& p, int item, int lane, LAS float* stg  ) {
    const int h = (item >> 4) & 15, rb = item & 15, b = item >> 8, r4 = lane >> 4, kq = lane & 15, rowv = rb * 4 + r4;
    const int row0 = SAMPLE ? SEQ + b * 4 : 0;
    float S0 = 0.f, S1 = 0.f, S2 = 0.f, S3 = 0.f;
    if (SAMPLE) { const f32x4 s = *(const f32x4*)(p.state_rwkv + ((size_t)(b * 16 + h) * 64 + rowv) * 64 + 4 * kq); S0 = s[0]; S1 = s[1]; S2 = s[2]; S3 = s[3]; }
    const float* sc = p.SC + (size_t)row0 * SCR + (size_t)h * SCH;
    float* ys = p.YS + ((size_t)row0 * 1024 + (size_t)h * 64 + rowv) * 2;
    if (SAMPLE) {
        ScanGrp x; scan_load(x, sc, 0, r4, kq, rowv);
        scan_group(x, stg, S0, S1, S2, S3, ys, r4, kq);
    } else {
        constexpr int G = 6, NG = SEQ / 4, NGM = (NG / G) * G;
        ScanGrp x[G];
#define SCAN_LOAD_ASM(X, gg) { const float* q_ = sc + (size_t)(4 * (gg) + r4) * SCR + 4 * kq; const float* qv_ = sc + (size_t)(4 * (gg) + (kq & 3)) * SCR + 320 + rowv; \
        asm volatile("global_load_dwordx4 %0, %5, off\n\tglobal_load_dwordx4 %1, %5, off offset:256\n\tglobal_load_dwordx4 %2, %5, off offset:512\n\tglobal_load_dwordx4 %3, %5, off offset:768\n\t" \
                     "global_load_dwordx4 %4, %5, off offset:1024" : "=&v"(X.kk), "=&v"(X.wr), "=&v"(X.ww), "=&v"(X.bb), "=&v"(X.kt) : "v"(q_) : "memory"); \
        asm volatile("global_load_dword %0, %1, off" : "=&v"(X.v) : "v"(qv_) : "memory"); }
#define SCAN_WAIT(X, N) asm volatile("s_waitcnt vmcnt(" #N ")" : "+v"(X.kk), "+v"(X.wr), "+v"(X.ww), "+v"(X.bb), "+v"(X.kt), "+v"(X.v) :: "memory")
#pragma unroll
        for (int i = 0; i < G; ++i) SCAN_LOAD_ASM(x[i], i);
        for (int g = 0; g < NGM - G; g += G) {
#pragma unroll
            for (int i = 0; i < G; ++i) {
                SCAN_WAIT(x[i], 36);
                float vj[4]; scan_stage(x[i], stg + (i & 1) * 1280, vj, r4, kq);
                __builtin_amdgcn_sched_barrier(0);
                SCAN_LOAD_ASM(x[i], g + i + G);
                __builtin_amdgcn_sched_barrier(0);
                scan_steps(vj, stg + (i & 1) * 1280, S0, S1, S2, S3, ys + (size_t)(g + i) * 4 * 2048, r4, kq);
            }
        }
#pragma unroll
        for (int i = 0; i < G; ++i) {
            SCAN_WAIT(x[i], 0);
            scan_group(x[i], stg + (i & 1) * 1280, S0, S1, S2, S3, ys + (size_t)(NGM - G + i) * 4 * 2048, r4, kq);
        }
#undef SCAN_LOAD_ASM
#undef SCAN_WAIT
        for (int g = NGM; g < NG; ++g) { ScanGrp y; scan_load(y, sc, g, r4, kq, rowv); scan_group(y, stg, S0, S1, S2, S3, ys + (size_t)g * 4 * 2048, r4, kq); }
    }
    float* so = SAMPLE ? p.o_state_s + (size_t)(b * 16 + h) * 4096 : p.o_state_p + (size_t)h * 4096;
    *(f32x4*)(so + (size_t)rowv * 64 + 4 * kq) = (f32x4){S0, S1, S2, S3};
}

__device__ __forceinline__ void rwkv_post_phase(const Params& p, int tid) {
    const int half = tid >> 8, t8 = tid & 255, c0 = t8 * 4, hd = t8 >> 4, cl = (t8 & 15) * 4;
    for (int base = blockIdx.x * 2; base < MT; base += gridDim.x * 2) {
        const int row = base + half;
        const size_t o = (size_t)row * 1024 + c0;
        const f32x4 ya = *(const f32x4*)(p.YS + o * 2), yb = *(const f32x4*)(p.YS + o * 2 + 4);
        const f32x4 v = *(const f32x4*)(p.SC + (size_t)row * SCR + hd * SCH + 320 + cl), g = *(const f32x4*)(p.G + o);
        const f32x4 cc = *(const f32x4*)(p.C12 + ((size_t)row * 16 + hd) * 4);
        f32x4 y;
        y[0] = ya[1] - ya[0] * cc[0] + v[0] * cc[1]; y[1] = ya[3] - ya[2] * cc[0] + v[1] * cc[1];
        y[2] = yb[1] - yb[0] * cc[0] + v[2] * cc[1]; y[3] = yb[3] - yb[2] * cc[0] + v[3] * cc[1];
        float s = (y[0] + y[1]) + (y[2] + y[3]);
        s += __shfl_xor(s, 1); s += __shfl_xor(s, 2); s += __shfl_xor(s, 4); s += __shfl_xor(s, 8);
        const f32x4 d = y - s * (1.f / 64.f);
        float q = d[0] * d[0] + d[1] * d[1] + d[2] * d[2] + d[3] * d[3];
        q += __shfl_xor(q, 1); q += __shfl_xor(q, 2); q += __shfl_xor(q, 4); q += __shfl_xor(q, 8);
        const float rs = rsqrtf(q * (1.f / 64.f) + 64e-5f);
        const f32x4 lw = *(const f32x4*)(p.rln_w + c0), lb = *(const f32x4*)(p.rln_b + c0);
        const f32x4 out = (d * rs * lw + lb + v * cc[2]) * g;
        u32x2 w; w.x = cvt_pk_bf16(out[0], out[1]); w.y = cvt_pk_bf16(out[2], out[3]);
        *(u32x2*)(p.ROb + o) = w;
    }
}

typedef float f32x16 __attribute__((ext_vector_type(16)));
constexpr int CA_LD = 264;
template <bool SAMPLE>
__device__ __forceinline__ void compress_phase(const Params& p, LAS unsigned char* ldsb, int tid, int wg, int nwg) {
    LAS bf16* Am = (LAS bf16*)ldsb;
    LAS bf16* Bm = Am + 2 * 64 * CA_LD;
    LAS float* waL = (LAS float*)(Bm + 2 * 64 * CA_LD);
    const int i = tid, s = i >> 8, hh = (i >> 6) & 3, d = i & 63, lane = tid & 63, w = tid >> 6;
    for (int e = tid; e < 2 * 4 * 64 * 64; e += NTHR) { const int ee = e & 63, dd = (e >> 6) & 63, r = (e >> 12) & 3, ss = e >> 14; Bm[(ss * 64 + ee) * CA_LD + r * 64 + dd] = (bf16)(cvt_pk_bf16(p.cmp_wb[e], 0.f) & 0xffffu); }
    if (tid < 256) waL[tid] = p.cmp_wa[tid];
    float pe4[4] = {0.f, 0.f, 0.f, 0.f};
    for (int l = 0; l < 32; ++l) { const float x = p.cmp_pe[(s * 32 + l) * 64 + d]; const float4 wv = *(const float4*)(p.cmp_wa + (s * 32 + l) * 4); pe4[0] += x * wv.x; pe4[1] += x * wv.y; pe4[2] += x * wv.z; pe4[3] += x * wv.w; }
    __syncthreads();
    const int nunits = SAMPLE ? 32 * 32 : 32;
    for (int unit = wg; unit < nunits; unit += nwg) {
        const int b = unit >> 5, c0 = (unit & 31) * 16;
        auto rowp = [&](int t) -> const float* {
            if (SAMPLE) { const int page = p.pt[b * 64 + (t >> 7)]; return p.cache_cmp + ((size_t)page * 128 + (t & 127)) * 512 + i; }
            return p.o_cmp_p + (size_t)t * 512 + i; };
        float x[16], Fp[4] = {0.f, 0.f, 0.f, 0.f};
#pragma unroll
        for (int l = 0; l < 16; ++l) x[l] = *rowp(c0 * 16 + l);
        for (int n = 0; n <= 16; ++n) {
            float F[4] = {0.f, 0.f, 0.f, 0.f}, G[4] = {0.f, 0.f, 0.f, 0.f};
#pragma unroll
            for (int l = 0; l < 16; ++l) {
                const f32x4 wf = *(const LAS f32x4*)(waL + (s * 32 + l) * 4), wg = *(const LAS f32x4*)(waL + (s * 32 + 16 + l) * 4);
                F[0] += x[l] * wf[0]; F[1] += x[l] * wf[1]; F[2] += x[l] * wf[2]; F[3] += x[l] * wf[3];
                G[0] += x[l] * wg[0]; G[1] += x[l] * wg[1]; G[2] += x[l] * wg[2]; G[3] += x[l] * wg[3];
            }
            if (n < 16 && c0 + n + 1 < 512) {
#pragma unroll
                for (int l = 0; l < 16; ++l) x[l] = *rowp((c0 + n + 1) * 16 + l);
            }
            if (n > 0) {
#pragma unroll
                for (int r = 0; r < 4; ++r) { const float v = Fp[r] + G[r] + pe4[r]; const float hv = v * __builtin_amdgcn_rcpf(1.f + __expf(-1.5957691216057308f * (v + 0.044715f * v * v * v)));
                    Am[(s * 64 + (n - 1) * 4 + hh) * CA_LD + r * 64 + d] = (bf16)(cvt_pk_bf16(hv, 0.f) & 0xffffu); }
            }
#pragma unroll
            for (int r = 0; r < 4; ++r) Fp[r] = F[r];
        }
        __syncthreads();
        {
            const int ws = w >> 2, mt = (w >> 1) & 1, nt = w & 1, l31 = lane & 31, kh = lane >> 5;
            f32x16 acc;
#pragma unroll
            for (int r = 0; r < 16; ++r) acc[r] = 0.f;
            const LAS bf16* ap = Am + (ws * 64 + mt * 32 + l31) * CA_LD + 8 * kh;
            const LAS bf16* bp = Bm + (ws * 64 + nt * 32 + l31) * CA_LD + 8 * kh;
#pragma unroll
            for (int ks = 0; ks < 16; ++ks) acc = __builtin_amdgcn_mfma_f32_32x32x16_bf16(*(const LAS bf16x8*)(ap + ks * 16), *(const LAS bf16x8*)(bp + ks * 16), acc, 0, 0, 0);
#pragma unroll
            for (int r = 0; r < 16; ++r) {
                const int row = mt * 32 + (r & 3) + 8 * (r >> 2) + 4 * kh, c = c0 + (row >> 2), h2 = row & 3, e = nt * 32 + l31;
                if (c < 511) {
                    if (SAMPLE) p.KCVs[((size_t)b * 511 + c) * 512 + ws * 256 + h2 * 64 + e] = acc[r];
                    else {
#ifdef NSA_CHECK
                        p.KCVp[(size_t)c * 512 + ws * 256 + h2 * 64 + e] = acc[r];
#endif
                        const bf16 ob = (bf16)(cvt_pk_bf16(acc[r], 0.f) & 0xffffu);
                        if (ws == 0) p.KCb[(size_t)h2 * 32768 + (size_t)(c >> 4) * 1024 + (e >> 5) * 512 + ((e >> 3) & 3) * 128 + (c & 15) * 8 + (e & 7)] = ob;
                        else { const int kl = c & 31, ta = kl >> 4, sx = (kl >> 2) & 3, jx = (kl & 3) + 4 * ta;
                               p.VCtb[(size_t)h2 * 32768 + (size_t)(c >> 5) * 2048 + (e >> 4) * 512 + (sx * 16 + (e & 15)) * 8 + jx] = ob; }
                    }
                }
            }
        }
        __syncthreads();
    }
}

__device__ __forceinline__ void dot4f(const float* __restrict__ kr, const LAS float* qs, float* s4) {
    float a0 = 0.f, a1 = 0.f, a2 = 0.f, a3 = 0.f;
#pragma unroll
    for (int d = 0; d < 64; d += 4) {
        const float4 k = *(const float4*)(kr + d);
        a0 += k.x * qs[d] + k.y * qs[d + 1] + k.z * qs[d + 2] + k.w * qs[d + 3];
        a1 += k.x * qs[64 + d] + k.y * qs[64 + d + 1] + k.z * qs[64 + d + 2] + k.w * qs[64 + d + 3];
        a2 += k.x * qs[128 + d] + k.y * qs[128 + d + 1] + k.z * qs[128 + d + 2] + k.w * qs[128 + d + 3];
        a3 += k.x * qs[192 + d] + k.y * qs[192 + d + 1] + k.z * qs[192 + d + 2] + k.w * qs[192 + d + 3];
    }
    s4[0] = a0; s4[1] = a1; s4[2] = a2; s4[3] = a3;
}
__device__ __forceinline__ void dot4h(const bf16* __restrict__ kr, const LAS float* qs, float* s4) {
    float a0 = 0.f, a1 = 0.f, a2 = 0.f, a3 = 0.f;
#pragma unroll
    for (int d = 0; d < 64; d += 8) {
        const u32x4 w = *(const u32x4*)(kr + d);
        const float k[8] = {bf_lo(w.x), bf_hi(w.x), bf_lo(w.y), bf_hi(w.y), bf_lo(w.z), bf_hi(w.z), bf_lo(w.w), bf_hi(w.w)};
#pragma unroll
        for (int j = 0; j < 8; ++j) { a0 += k[j] * qs[d + j]; a1 += k[j] * qs[64 + d + j]; a2 += k[j] * qs[128 + d + j]; a3 += k[j] * qs[192 + d + j]; }
    }
    s4[0] = a0; s4[1] = a1; s4[2] = a2; s4[3] = a3;
}
__device__ __forceinline__ void dot4h_frag(const bf16* __restrict__ kmat, int kp, const LAS float* qs, float* s4) {
    float a0 = 0.f, a1 = 0.f, a2 = 0.f, a3 = 0.f;
#pragma unroll
    for (int d = 0; d < 64; d += 8) {
        const u32x4 w = *(const u32x4*)(kmat + (size_t)(kp >> 4) * 1024 + (d >> 5) * 512 + ((d >> 3) & 3) * 128 + (kp & 15) * 8);
        const float k[8] = {bf_lo(w.x), bf_hi(w.x), bf_lo(w.y), bf_hi(w.y), bf_lo(w.z), bf_hi(w.z), bf_lo(w.w), bf_hi(w.w)};
#pragma unroll
        for (int j = 0; j < 8; ++j) { a0 += k[j] * qs[d + j]; a1 += k[j] * qs[64 + d + j]; a2 += k[j] * qs[128 + d + j]; a3 += k[j] * qs[192 + d + j]; }
    }
    s4[0] = a0; s4[1] = a1; s4[2] = a2; s4[3] = a3;
}
__device__ __forceinline__ void wave_softmax(LAS float* s, int n, int lane) {
    float m = NEG;
    for (int i = lane; i < n; i += 64) m = fmaxf(m, s[i]);
    m = wave_max(m);
    float l = 0.f;
    for (int i = lane; i < n; i += 64) { const float x = s[i]; const float pv = (x <= NEG) ? 0.f : exp2f(x - m); s[i] = pv; l += pv; }
    l = wave_sum(l);
    const float inv = l > 0.f ? 1.f / l : 0.f;
    for (int i = lane; i < n; i += 64) s[i] *= inv;
}
__device__ __forceinline__ float bf_at(const bf16* p) { return __uint_as_float(((unsigned)*p) << 16); }

#ifdef NSA_CHECK
template <bool SAMPLE>
__device__ __forceinline__ void nsa_phase(const Params& p, LAS unsigned char* ldsb, int tid) {
    const int half = tid >> 8, t8 = tid & 255, lane = tid & 63, g = (tid >> 6) & 3;
    LAS float* qs = (LAS float*)(ldsb + half * 20480);
    LAS float* sc = qs + 256;
    LAS float* impv = sc + 4096;
    LAS int* selb = (LAS int*)(impv + 132);
    const int nitems = SAMPLE ? NS * 4 : SEQ * 4;
    const int nblk = SAMPLE ? 129 : 128;
    for (int base = blockIdx.x * 2; base < nitems; base += gridDim.x * 2) {
        const int item = base + half;
        const int kvh = item & 3, qi = item >> 2;
        const int b = SAMPLE ? (qi >> 2) : 0, tq = SAMPLE ? (qi & 3) : qi;
        const int pos = SAMPLE ? PAST + tq : tq;
        const int row = SAMPLE ? SEQ + qi : qi;
        qs[g * 64 + lane] = bf_at(p.Qb + (size_t)row * 1024 + (kvh * 4 + g) * 64 + lane);
        const float* gn = p.UA + (size_t)row * UAW + RCOLS;
        const float g0 = sigm(gn[0 * 16 + kvh * 4 + g]), g1 = sigm(gn[1 * 16 + kvh * 4 + g]), g2 = sigm(gn[2 * 16 + kvh * 4 + g]);
        __syncthreads();
        float oacc = 0.f;
        {
#ifdef NSA_CHECK
            const float* kcv = SAMPLE ? p.KCVs + (size_t)b * 511 * 512 : p.KCVp;
#else
            const float* kcv = p.KCVs + (size_t)b * 511 * 512;
#endif
            for (int c = t8; c < 511; c += 256) {
                float s4[4] = {NEG, NEG, NEG, NEG};
                if (c * 16 + 31 <= pos) dot4f(kcv + (size_t)c * 512 + kvh * 64, qs, s4);
                sc[c] = s4[0]; sc[1024 + c] = s4[1]; sc[2048 + c] = s4[2]; sc[3072 + c] = s4[3];
            }
            __syncthreads();
            wave_softmax(sc + g * 1024, 511, lane);
            __syncthreads();
            float o = 0.f;
            for (int c = 0; c < 511; ++c) { const float pv = sc[g * 1024 + c]; if (pv != 0.f) o += pv * kcv[(size_t)c * 512 + 256 + kvh * 64 + lane]; }
            oacc += g0 * o;
            if (t8 < nblk) {
                float s = 0.f;
                for (int cc = 4 * t8; cc < 4 * t8 + 4; ++cc) if (cc < 511) s += (sc[cc] + sc[1024 + cc]) + (sc[2048 + cc] + sc[3072 + cc]);
                const int cur = pos >> 6;
                const bool forced = (t8 == 0) || (t8 == cur) || (t8 == cur - 1);
                const bool future = t8 * 64 > pos;
                impv[t8] = future ? -1e9f : (forced ? 1e9f : s);
            }
            __syncthreads();
            if (g == 0) {
                float cs0 = lane < nblk ? impv[lane] : NEG, cs1 = (lane + 64) < nblk ? impv[lane + 64] : NEG, cs2 = (lane + 128) < nblk ? impv[lane + 128] : NEG;
                for (int it = 0; it < 16; ++it) {
                    float bs = cs0; int bi = lane;
                    if (cs1 > bs) { bs = cs1; bi = lane + 64; }
                    if (cs2 > bs) { bs = cs2; bi = lane + 128; }
                    for (int off = 32; off >= 1; off >>= 1) {
                        const float os = __shfl_xor(bs, off); const int oi = __shfl_xor(bi, off);
                        if (os > bs || (os == bs && oi < bi)) { bs = os; bi = oi; }
                    }
                    if (lane == 0) selb[it] = bi;
                    if (bi == lane) cs0 = NEG;
                    if (bi == lane + 64) cs1 = NEG;
                    if (bi == lane + 128) cs2 = NEG;
                }
            }
            __syncthreads();
        }
        {
            for (int i = t8; i < 1024; i += 256) {
                const int j = selb[i >> 6], l = i & 63, kp = j * 64 + l;
                float s4[4] = {NEG, NEG, NEG, NEG};
                if (kp <= pos) {
                    if (SAMPLE && j < 128) dot4f(p.cache_sel + ((size_t)p.pt[b * 64 + (j >> 1)] * 128 + (j & 1) * 64 + l) * 512 + kvh * 64, qs, s4);
                    else dot4h_frag(p.Kc + (size_t)(4 + kvh) * MP * 64, (SAMPLE ? SEQ + b * 4 + l : kp), qs, s4);
                }
                sc[i] = s4[0]; sc[1024 + i] = s4[1]; sc[2048 + i] = s4[2]; sc[3072 + i] = s4[3];
            }
            __syncthreads();
            wave_softmax(sc + g * 1024, 1024, lane);
            __syncthreads();
            float o = 0.f;
            for (int i = 0; i < 1024; ++i) {
                const float pv = sc[g * 1024 + i];
                if (pv != 0.f) {
                    const int j = selb[i >> 6], l = i & 63;
                    float vv;
                    if (SAMPLE && j < 128) vv = p.cache_sel[((size_t)p.pt[b * 64 + (j >> 1)] * 128 + (j & 1) * 64 + l) * 512 + 256 + kvh * 64 + lane];
                    else vv = bf_at(p.Vc + ((size_t)(4 + kvh) * MP + (SAMPLE ? SEQ + b * 4 + l : j * 64 + l)) * 64 + lane);
                    o += pv * vv;
                }
            }
            oacc += g1 * o;
            __syncthreads();
        }
        {
            for (int i = t8; i < 512; i += 256) {
                const int kp = pos - 511 + i;
                float s4[4] = {NEG, NEG, NEG, NEG};
                if (kp >= 0) {
                    if (SAMPLE && kp < PAST) dot4f(p.state_win + ((size_t)b * 512 + (kp - (PAST - 512))) * 512 + kvh * 64, qs, s4);
                    else dot4h_frag(p.Kc + (size_t)(8 + kvh) * MP * 64, (SAMPLE ? SEQ + b * 4 + (kp - PAST) : kp), qs, s4);
                }
                sc[i] = s4[0]; sc[1024 + i] = s4[1]; sc[2048 + i] = s4[2]; sc[3072 + i] = s4[3];
            }
            __syncthreads();
            wave_softmax(sc + g * 1024, 512, lane);
            __syncthreads();
            float o = 0.f;
            for (int i = 0; i < 512; ++i) {
                const float pv = sc[g * 1024 + i];
                if (pv != 0.f) {
                    const int kp = pos - 511 + i;
                    float vv;
                    if (SAMPLE && kp < PAST) vv = p.state_win[((size_t)b * 512 + (kp - (PAST - 512))) * 512 + 256 + kvh * 64 + lane];
                    else vv = bf_at(p.Vc + ((size_t)(8 + kvh) * MP + (SAMPLE ? SEQ + b * 4 + (kp - PAST) : kp)) * 64 + lane);
                    o += pv * vv;
                }
            }
            oacc += g2 * o;
        }
#ifdef NSA_CHECK
        if (!SAMPLE) p.Ob2[(size_t)row * 1024 + (kvh * 4 + g) * 64 + lane] = oacc; else
#endif
        p.Ob[(size_t)row * 1024 + (kvh * 4 + g) * 64 + lane] = (bf16)(cvt_pk_bf16(oacc, 0.f) & 0xffffu);
        __syncthreads();
    }
}

#endif
template <class RowF>
__device__ __forceinline__ void samp_scores(int n, RowF rowp, const LAS float* qs, LAS float* sc, int kvh, int tid) {
    for (int i = tid; i < n; i += NTHR) { float s4[4]; dot4f(rowp(i) + kvh * 64, qs, s4); sc[i] = s4[0]; sc[1024 + i] = s4[1]; sc[2048 + i] = s4[2]; sc[3072 + i] = s4[3]; }
}
template <class RowF>
__device__ __forceinline__ void samp_pv(int n, int chunk, RowF rowp, const LAS float* sc, LAS float* part, int kvh, int w, int lane) {
    float a0 = 0.f, a1 = 0.f, a2 = 0.f, a3 = 0.f;
    const int k0 = w * chunk, k1 = (k0 + chunk < n) ? k0 + chunk : n;
    int k = k0;
    for (; k + 8 <= k1; k += 8) {
        float v[8];
#pragma unroll
        for (int j = 0; j < 8; ++j) v[j] = rowp(k + j)[256 + kvh * 64 + lane];
#pragma unroll
        for (int j = 0; j < 8; ++j) { a0 += sc[k + j] * v[j]; a1 += sc[1024 + k + j] * v[j]; a2 += sc[2048 + k + j] * v[j]; a3 += sc[3072 + k + j] * v[j]; }
    }
    for (; k < k1; ++k) { const float v = rowp(k)[256 + kvh * 64 + lane]; a0 += sc[k] * v; a1 += sc[1024 + k] * v; a2 += sc[2048 + k] * v; a3 += sc[3072 + k] * v; }
    part[w * 256 + lane] = a0; part[w * 256 + 64 + lane] = a1; part[w * 256 + 128 + lane] = a2; part[w * 256 + 192 + lane] = a3;
}
__device__ __forceinline__ void nsa_sample_phase(const Params& p, LAS unsigned char* ldsb, int tid, int wg, int nwg) {
    const int lane = tid & 63, w = tid >> 6;
    LAS float* qs = (LAS float*)ldsb;
    LAS float* sc = qs + 256;
    LAS float* impv = sc + 4096;
    LAS int* selb = (LAS int*)(impv + 136);
    LAS float* part = (LAS float*)(selb + 16);
    for (int item = wg; item < NS * 4; item += nwg) {
        const int kvh = item & 3, qi = item >> 2, b = qi >> 2, tq = qi & 3, pos = PAST + tq, row = SEQ + qi;
        float g0 = 0.f, g1 = 0.f, g2 = 0.f, oacc = 0.f;
        if (tid < 256) {
            qs[tid] = bf_at(p.Qb + (size_t)row * 1024 + kvh * 256 + tid);
            const float* gn = p.UA + (size_t)row * UAW + RCOLS + kvh * 4 + (tid >> 6);
            g0 = sigm(gn[0]); g1 = sigm(gn[16]); g2 = sigm(gn[32]);
        }
        __syncthreads();
        {
            const float* kcv = p.KCVs + (size_t)b * 511 * 512;
            auto rowp = [&](int c) { return kcv + (size_t)c * 512; };
            samp_scores(511, rowp, qs, sc, kvh, tid);
            __syncthreads();
            if (w < 4) wave_softmax(sc + w * 1024, 511, lane);
            __syncthreads();
            samp_pv(511, 64, rowp, sc, part, kvh, w, lane);
            if (tid < 129) {
                float s = 0.f;
                for (int cc = 4 * tid; cc < 4 * tid + 4; ++cc) if (cc < 511) s += (sc[cc] + sc[1024 + cc]) + (sc[2048 + cc] + sc[3072 + cc]);
                const bool forced = (tid == 0) || (tid == 128) || (tid == 127);
                impv[tid] = forced ? 1e9f : s;
            }
            __syncthreads();
            if (tid < 256) { float o = 0.f;
#pragma unroll
                for (int ww = 0; ww < 8; ++ww) o += part[ww * 256 + tid];
                oacc += g0 * o; }
            if (w == 0) {
                float cs0 = impv[lane], cs1 = impv[lane + 64], cs2 = (lane + 128) < 129 ? impv[lane + 128] : NEG;
                for (int it = 0; it < 16; ++it) {
                    float bs = cs0; int bi = lane;
                    if (cs1 > bs) { bs = cs1; bi = lane + 64; }
                    if (cs2 > bs) { bs = cs2; bi = lane + 128; }
                    for (int off = 32; off >= 1; off >>= 1) { const float os = __shfl_xor(bs, off); const int oi = __shfl_xor(bi, off); if (os > bs || (os == bs && oi < bi)) { bs = os; bi = oi; } }
                    if (lane == 0) selb[it] = bi;
                    if (bi == lane) cs0 = NEG;
                    if (bi == lane + 64) cs1 = NEG;
                    if (bi == lane + 128) cs2 = NEG;
                }
            }
            __syncthreads();
        }
        {
            auto rowp = [&](int i) { const int j = selb[i >> 6], l = i & 63;
                return (j < 128) ? p.cache_sel + ((size_t)p.pt[b * 64 + (j >> 1)] * 128 + (j & 1) * 64 + l) * 512 : p.o_sel_s + (size_t)(b * 4 + (l & 3)) * 512; };
            samp_scores(1024, rowp, qs, sc, kvh, tid);
            __syncthreads();
            for (int i = tid; i < 1024; i += NTHR) if (selb[i >> 6] == 128 && (i & 63) > tq) { sc[i] = NEG; sc[1024 + i] = NEG; sc[2048 + i] = NEG; sc[3072 + i] = NEG; }
            __syncthreads();
            if (w < 4) wave_softmax(sc + w * 1024, 1024, lane);
            __syncthreads();
            samp_pv(1024, 128, rowp, sc, part, kvh, w, lane);
            __syncthreads();
            if (tid < 256) { float o = 0.f;
#pragma unroll
                for (int ww = 0; ww < 8; ++ww) o += part[ww * 256 + tid];
                oacc += g1 * o; }
            __syncthreads();
        }
        {
            auto rowp = [&](int i) { const int kp = pos - 511 + i;
                return (kp < PAST) ? p.state_win + ((size_t)b * 512 + (kp - (PAST - 512))) * 512 : p.o_win_s + ((size_t)b * 512 + 508 + (kp - PAST)) * 512 + 1024 - 1024; };
            samp_scores(512, rowp, qs, sc, kvh, tid);
            __syncthreads();
            if (w < 4) wave_softmax(sc + w * 1024, 512, lane);
            __syncthreads();
            samp_pv(512, 64, rowp, sc, part, kvh, w, lane);
            __syncthreads();
            if (tid < 256) { float o = 0.f;
#pragma unroll
                for (int ww = 0; ww < 8; ++ww) o += part[ww * 256 + tid];
                oacc += g2 * o;
                p.Ob[(size_t)row * 1024 + kvh * 256 + tid] = (bf16)(cvt_pk_bf16(oacc, 0.f) & 0xffffu); }
            __syncthreads();
        }
    }
}

__device__ __forceinline__ void vtrans_phase(const Params& p, LAS bf16* tile  , int tid, int wg, int nwg) {
    for (int item = wg; item < 2 * 4 * 128; item += nwg) {
        const int blk = item & 127, kvh = (item >> 7) & 3, br = item >> 9;
        { const int r = tid >> 3, d8 = (tid & 7) * 8;
          const u32x4 w = *(const u32x4*)(p.Vc + ((size_t)((br + 1) * 4 + kvh) * MP + blk * 64 + r) * 64 + d8);
          *(LAS u32x4*)(tile + r * 72 + d8) = w; }
        __syncthreads();
        { const int hf = tid >> 8, nt = (tid >> 6) & 3, ln = tid & 63, sx = ln >> 4, dim = nt * 16 + (ln & 15); unsigned short e[8];
#pragma unroll
          for (int j = 0; j < 8; ++j) e[j] = tile[(hf * 32 + (j >> 2) * 16 + 4 * sx + (j & 3)) * 72 + dim];
          u32x4 w; w.x = e[0] | ((unsigned)e[1] << 16); w.y = e[2] | ((unsigned)e[3] << 16); w.z = e[4] | ((unsigned)e[5] << 16); w.w = e[6] | ((unsigned)e[7] << 16);
          *(u32x4*)(p.Vtb + ((size_t)br * 4 + kvh) * 128 * 4096 + (size_t)(blk * 2 + hf) * 2048 + nt * 512 + ln * 8) = w; }
        __syncthreads();
    }
}

constexpr float MNEG = -1.0e30f;
struct AttnState { float m, l; f32x4 O[4]; };
__device__ __forceinline__ void attn_reset(AttnState& a) { a.m = MNEG; a.l = 0.f;
#pragma unroll
    for (int i = 0; i < 4; ++i) a.O[i] = (f32x4){0.f, 0.f, 0.f, 0.f}; }
struct KVFrag { bf16x8 Ka0, Ka1, Kb0, Kb1; bf16x8 V[4]; };
__device__ __forceinline__ void kv_load(KVFrag& f, const bf16* __restrict__ kt, const bf16* __restrict__ vs, int lane) {
    f.Ka0 = *(const bf16x8*)(kt + lane * 8); f.Ka1 = *(const bf16x8*)(kt + 512 + lane * 8);
    f.Kb0 = *(const bf16x8*)(kt + 1024 + lane * 8); f.Kb1 = *(const bf16x8*)(kt + 1536 + lane * 8);
#pragma unroll
    for (int nt = 0; nt < 4; ++nt) f.V[nt] = *(const bf16x8*)(vs + nt * 512 + lane * 8);
}
__device__ __forceinline__ void attn_compute(AttnState& a, const KVFrag& f, const bf16x8 Q0, const bf16x8 Q1, const bool (&ok)[8]) {
    f32x4 Sa = {0.f, 0.f, 0.f, 0.f}, Sb = {0.f, 0.f, 0.f, 0.f};
    Sa = __builtin_amdgcn_mfma_f32_16x16x32_bf16(f.Ka0, Q0, Sa, 0, 0, 0); Sa = __builtin_amdgcn_mfma_f32_16x16x32_bf16(f.Ka1, Q1, Sa, 0, 0, 0);
    Sb = __builtin_amdgcn_mfma_f32_16x16x32_bf16(f.Kb0, Q0, Sb, 0, 0, 0); Sb = __builtin_amdgcn_mfma_f32_16x16x32_bf16(f.Kb1, Q1, Sb, 0, 0, 0);
    float sc[8] = {Sa[0], Sa[1], Sa[2], Sa[3], Sb[0], Sb[1], Sb[2], Sb[3]};
    float mx = MNEG;
#pragma unroll
    for (int i = 0; i < 8; ++i) { sc[i] = ok[i] ? sc[i] : MNEG; mx = fmaxf(mx, sc[i]); }
    if (__any(mx > a.m + 8.f)) {
        mx = fmaxf(mx, __shfl_xor(mx, 16)); mx = fmaxf(mx, __shfl_xor(mx, 32));
        const float mn = fmaxf(a.m, mx), scale = __builtin_amdgcn_exp2f(a.m - mn);
        a.m = mn; a.l *= scale;
#pragma unroll
        for (int nt = 0; nt < 4; ++nt) a.O[nt] *= scale;
    }
    const float mref = a.m;
    float pv[8], ps = 0.f;
#pragma unroll
    for (int i = 0; i < 8; ++i) { pv[i] = ok[i] ? __builtin_amdgcn_exp2f(sc[i] - mref) : 0.f; ps += pv[i]; }
    a.l += ps;
    union { bf16x8 v; unsigned u[4]; } P;
    P.u[0] = cvt_pk_bf16(pv[0], pv[1]); P.u[1] = cvt_pk_bf16(pv[2], pv[3]); P.u[2] = cvt_pk_bf16(pv[4], pv[5]); P.u[3] = cvt_pk_bf16(pv[6], pv[7]);
#pragma unroll
    for (int nt = 0; nt < 4; ++nt) a.O[nt] = __builtin_amdgcn_mfma_f32_16x16x32_bf16(f.V[nt], P.v, a.O[nt], 0, 0, 0);
}
__device__ __forceinline__ void attn_finish(const AttnState& a, float gate, f32x4 (&acc)[4]) {
    float L = a.l; L += __shfl_xor(L, 16); L += __shfl_xor(L, 32);
    const float f = L > 0.f ? gate / L : 0.f;
#pragma unroll
    for (int nt = 0; nt < 4; ++nt) acc[nt] += a.O[nt] * f;
}

__device__ __forceinline__ void nsa_prompt_item(const Params& p, int item, int lane, LAS float* impL  , LAS int* selL  , LAS int* stepL  ) {
    const int kvh = item & 3, t0 = (2047 - (item >> 2)) * 4;
    const int col = lane & 15, s = lane >> 4, q = col >> 2, g = col & 3, tq = t0 + q;
    const bf16* qrow = p.Qb + (size_t)tq * 1024 + (kvh * 4 + g) * 64;
    const bf16x8 Q0 = *(const bf16x8*)(qrow + 8 * s), Q1 = *(const bf16x8*)(qrow + 32 + 8 * s);
    const float* gn = p.UA + (size_t)tq * UAW + RCOLS + kvh * 4 + g;
    const float g0 = sigm(gn[0]), g1 = sigm(gn[16]), g2 = sigm(gn[32]);
    f32x4 acc[4] = {{0.f, 0.f, 0.f, 0.f}, {0.f, 0.f, 0.f, 0.f}, {0.f, 0.f, 0.f, 0.f}, {0.f, 0.f, 0.f, 0.f}};
    AttnState st;
    impL[lane] = 0.f; impL[64 + lane] = 0.f; impL[128 + lane] = 0.f; impL[192 + lane] = 0.f; impL[256 + lane] = 0.f; impL[320 + lane] = 0.f; impL[384 + lane] = 0.f; impL[448 + lane] = 0.f;
    {
        const int ncv = (t0 >= 28) ? ((t0 - 28) >> 4) + 1 : 0, nst = (ncv + 31) >> 5;
        const bf16* kc = p.KCb + (size_t)kvh * 512 * 64;
        const bf16* vc = p.VCtb + (size_t)kvh * 8 * 64 * 64;
        float m1 = MNEG, l1 = 0.f;
        for (int st1 = 0; st1 < nst; ++st1) {
            const int c0 = st1 * 32;
            const bf16* kt = kc + (size_t)c0 * 64;
            const bf16x8 Ka0 = *(const bf16x8*)(kt + lane * 8), Ka1 = *(const bf16x8*)(kt + 512 + lane * 8), Kb0 = *(const bf16x8*)(kt + 1024 + lane * 8), Kb1 = *(const bf16x8*)(kt + 1536 + lane * 8);
            f32x4 Sa = {0.f, 0.f, 0.f, 0.f}, Sb = {0.f, 0.f, 0.f, 0.f};
            Sa = __builtin_amdgcn_mfma_f32_16x16x32_bf16(Ka0, Q0, Sa, 0, 0, 0); Sa = __builtin_amdgcn_mfma_f32_16x16x32_bf16(Ka1, Q1, Sa, 0, 0, 0);
            Sb = __builtin_amdgcn_mfma_f32_16x16x32_bf16(Kb0, Q0, Sb, 0, 0, 0); Sb = __builtin_amdgcn_mfma_f32_16x16x32_bf16(Kb1, Q1, Sb, 0, 0, 0);
            float sc[8] = {Sa[0], Sa[1], Sa[2], Sa[3], Sb[0], Sb[1], Sb[2], Sb[3]};
            float mx = MNEG;
#pragma unroll
            for (int i = 0; i < 8; ++i) { const int c = c0 + (i >> 2) * 16 + 4 * s + (i & 3); sc[i] = (c * 16 + 31 <= tq) ? sc[i] : MNEG; mx = fmaxf(mx, sc[i]); }
            mx = fmaxf(mx, __shfl_xor(mx, 16)); mx = fmaxf(mx, __shfl_xor(mx, 32));
            const float mn = fmaxf(m1, mx);
            float ps = 0.f;
#pragma unroll
            for (int i = 0; i < 8; ++i) ps += (sc[i] > MNEG) ? __builtin_amdgcn_exp2f(sc[i] - mn) : 0.f;
            l1 = l1 * __builtin_amdgcn_exp2f(m1 - mn) + ps; m1 = mn;
        }
        l1 += __shfl_xor(l1, 16); l1 += __shfl_xor(l1, 32);
        const float il = l1 > 0.f ? 1.f / l1 : 0.f;
        attn_reset(st);
        for (int st1 = 0; st1 < nst; ++st1) {
            const int c0 = st1 * 32;
            const bf16* kt = kc + (size_t)c0 * 64;
            const bf16x8 Ka0 = *(const bf16x8*)(kt + lane * 8), Ka1 = *(const bf16x8*)(kt + 512 + lane * 8), Kb0 = *(const bf16x8*)(kt + 1024 + lane * 8), Kb1 = *(const bf16x8*)(kt + 1536 + lane * 8);
            bf16x8 Vf[4];
#pragma unroll
            for (int nt = 0; nt < 4; ++nt) Vf[nt] = *(const bf16x8*)(vc + (size_t)c0 * 64 + nt * 512 + lane * 8);
            f32x4 Sa = {0.f, 0.f, 0.f, 0.f}, Sb = {0.f, 0.f, 0.f, 0.f};
            Sa = __builtin_amdgcn_mfma_f32_16x16x32_bf16(Ka0, Q0, Sa, 0, 0, 0); Sa = __builtin_amdgcn_mfma_f32_16x16x32_bf16(Ka1, Q1, Sa, 0, 0, 0);
            Sb = __builtin_amdgcn_mfma_f32_16x16x32_bf16(Kb0, Q0, Sb, 0, 0, 0); Sb = __builtin_amdgcn_mfma_f32_16x16x32_bf16(Kb1, Q1, Sb, 0, 0, 0);
            const float sc[8] = {Sa[0], Sa[1], Sa[2], Sa[3], Sb[0], Sb[1], Sb[2], Sb[3]};
            float pv[8];
#pragma unroll
            for (int i = 0; i < 8; ++i) { const int c = c0 + (i >> 2) * 16 + 4 * s + (i & 3); pv[i] = (c * 16 + 31 <= tq) ? __builtin_amdgcn_exp2f(sc[i] - m1) * il : 0.f; }
            float ia = (pv[0] + pv[1]) + (pv[2] + pv[3]), ib = (pv[4] + pv[5]) + (pv[6] + pv[7]);
            ia += __shfl_xor(ia, 1); ia += __shfl_xor(ia, 2); ib += __shfl_xor(ib, 1); ib += __shfl_xor(ib, 2);
            if (g == 0) { impL[q * 128 + (c0 >> 2) + s] = ia; impL[q * 128 + (c0 >> 2) + 4 + s] = ib; }
            union { bf16x8 v; unsigned u[4]; } P;
            P.u[0] = cvt_pk_bf16(pv[0], pv[1]); P.u[1] = cvt_pk_bf16(pv[2], pv[3]); P.u[2] = cvt_pk_bf16(pv[4], pv[5]); P.u[3] = cvt_pk_bf16(pv[6], pv[7]);
#pragma unroll
            for (int nt = 0; nt < 4; ++nt) st.O[nt] = __builtin_amdgcn_mfma_f32_16x16x32_bf16(Vf[nt], P.v, st.O[nt], 0, 0, 0);
        }
#pragma unroll
        for (int nt = 0; nt < 4; ++nt) acc[nt] += st.O[nt] * g0;
    }
    asm volatile("s_waitcnt lgkmcnt(0)" ::: "memory");
    {
        const int qq = lane >> 4, li = lane & 15, tqq = t0 + qq, cur = tqq >> 6;
        float cs[8];
#pragma unroll
        for (int r = 0; r < 8; ++r) { const int j = li + 16 * r; const bool forced = (j == 0) || (j == cur) || (j == cur - 1); cs[r] = (j * 64 > tqq) ? -1e9f : (forced ? 1e9f : impL[qq * 128 + j]); }
        for (int it = 0; it < 16; ++it) {
            float bs = cs[0]; int bi = li;
#pragma unroll
            for (int r = 1; r < 8; ++r) if (cs[r] > bs) { bs = cs[r]; bi = li + 16 * r; }
#pragma unroll
            for (int off = 8; off >= 1; off >>= 1) { const float os = __shfl_xor(bs, off); const int oi = __shfl_xor(bi, off); if (os > bs || (os == bs && oi < bi)) { bs = os; bi = oi; } }
            if (li == 0) selL[qq * 16 + it] = bi;
#pragma unroll
            for (int r = 0; r < 8; ++r) if (bi == li + 16 * r) cs[r] = NEG;
        }
    }
    asm volatile("s_waitcnt lgkmcnt(0)" ::: "memory");
    {
        const bf16* kbase = p.Kc + (size_t)(4 + kvh) * MP * 64;
        const bf16* vbase = p.Vtb + (size_t)(0 * 4 + kvh) * 128 * 4096;
        int nstep;
        {
            const int cur = t0 >> 6, nf = 1 + (cur > 1 ? 1 : 0) + (cur > 0 ? 1 : 0);
            if (lane < nf) { const int jf = (lane == 0) ? 0 : ((lane == 1 && cur > 1) ? cur - 1 : cur); stepL[2 * lane] = (jf * 64) | (4 << 16); stepL[2 * lane + 1] = (jf * 64 + 32) | (4 << 16); }
            const int qs = lane >> 4, j = selL[lane]; const bool valid = (j * 64 <= t0 + qs) && !(j == 0 || j == cur || j == cur - 1);
            const unsigned long long mask = __ballot(valid);
            const int posn = nf + __popcll(mask & ((1ull << lane) - 1ull));
            if (valid) { stepL[2 * posn] = (j * 64) | (qs << 16); stepL[2 * posn + 1] = (j * 64 + 32) | (qs << 16); }
            nstep = 2 * (nf + __popcll(mask)); }
        asm volatile("s_waitcnt lgkmcnt(0)" ::: "memory");
        attn_reset(st);
        KVFrag F0, F1, F2;
#define SEL_LOAD(F, e_) { const int k0_ = (e_) & 0xffff; kv_load(F, kbase + (size_t)k0_ * 64, vbase + (size_t)k0_ * 64, lane); }
#define SEL_COMP(F, e_) { const int k0_ = (e_) & 0xffff, qs_ = (e_) >> 16; const int lim_ = (qs_ == 4 || q == qs_) ? tq - k0_ - 4 * s : -1; bool ok[8]; \
            _Pragma("unroll") for (int i2 = 0; i2 < 8; ++i2) ok[i2] = ((i2 >> 2) * 16 + (i2 & 3) <= lim_); attn_compute(st, F, Q0, Q1, ok); }
        if (nstep > 0) {
            const int last = nstep - 1;
            int e0 = __builtin_amdgcn_readfirstlane(stepL[0]), e1 = __builtin_amdgcn_readfirstlane(stepL[1 < nstep ? 1 : last]), e2 = __builtin_amdgcn_readfirstlane(stepL[2 < nstep ? 2 : last]);
            SEL_LOAD(F0, e0); SEL_LOAD(F1, e1); SEL_LOAD(F2, e2);
            __builtin_amdgcn_sched_barrier(0);
            for (int i = 0; i < nstep; i += 3) {
                int ev = stepL[i + 3 < nstep ? i + 3 : last];
                SEL_COMP(F0, e0);
                e0 = __builtin_amdgcn_readfirstlane(ev); SEL_LOAD(F0, e0);
                __builtin_amdgcn_sched_barrier(0);
                ev = stepL[i + 4 < nstep ? i + 4 : last];
                if (i + 1 < nstep) SEL_COMP(F1, e1);
                e1 = __builtin_amdgcn_readfirstlane(ev); SEL_LOAD(F1, e1);
                __builtin_amdgcn_sched_barrier(0);
                ev = stepL[i + 5 < nstep ? i + 5 : last];
                if (i + 2 < nstep) SEL_COMP(F2, e2);
                e2 = __builtin_amdgcn_readfirstlane(ev); SEL_LOAD(F2, e2);
                __builtin_amdgcn_sched_barrier(0);
            }
        }
#undef SEL_LOAD
#undef SEL_COMP
        attn_finish(st, g1, acc);
    }
    {
        const bf16* kbase = p.Kc + (size_t)(8 + kvh) * MP * 64;
        const bf16* vbase = p.Vtb + (size_t)(1 * 4 + kvh) * 128 * 4096;
        attn_reset(st);
        const int lo = (t0 >= 511 ? t0 - 511 : 0) & ~31, nst = ((t0 + 3 - lo) >> 5) + 1;
        KVFrag F0, F1;
#define WIN_LOAD(F, i) { const int k0_ = lo + 32 * (i); kv_load(F, kbase + (size_t)k0_ * 64, vbase + (size_t)k0_ * 64, lane); }
#define WIN_COMP(F, i) { const int k0_ = lo + 32 * (i); bool ok[8]; \
            _Pragma("unroll") for (int ii = 0; ii < 8; ++ii) { const int kp = k0_ + (ii >> 2) * 16 + 4 * s + (ii & 3); ok[ii] = (kp <= tq) && (kp > tq - 512); } attn_compute(st, F, Q0, Q1, ok); }
        WIN_LOAD(F0, 0);
        __builtin_amdgcn_sched_barrier(0);
        for (int i = 0; i < nst; i += 2) {
            WIN_LOAD(F1, (i + 1 < nst ? i + 1 : i));
            __builtin_amdgcn_sched_barrier(0);
            WIN_COMP(F0, i);
            WIN_LOAD(F0, (i + 2 < nst ? i + 2 : i));
            __builtin_amdgcn_sched_barrier(0);
            if (i + 1 < nst) WIN_COMP(F1, i + 1);
        }
#undef WIN_LOAD
#undef WIN_COMP
        attn_finish(st, g2, acc);
    }
    bf16* orow = p.Ob + (size_t)tq * 1024 + (kvh * 4 + g) * 64 + 4 * s;
#pragma unroll
    for (int nt = 0; nt < 4; ++nt) { u32x2 w; w.x = cvt_pk_bf16(acc[nt][0], acc[nt][1]); w.y = cvt_pk_bf16(acc[nt][2], acc[nt][3]); *(u32x2*)(orow + nt * 16) = w; }
}

__global__ void __launch_bounds__(NTHR, 2) mega_fwd(Params p) {
    extern __shared__ __attribute__((aligned(16))) unsigned char shm[];
    LAS unsigned char* lds = (LAS unsigned char*)shm;
#define PHASE_IDS int tid = threadIdx.x; asm volatile("" : "+v"(tid)); const int lane = tid & 63, wid = tid >> 6, gw = blockIdx.x * 8 + wid, nw = gridDim.x * 8; (void)lane; (void)gw; (void)nw; \
    const size_t gtid = (size_t)blockIdx.x * NTHR + tid, gthreads = (size_t)gridDim.x * NTHR; (void)gtid; (void)gthreads;
    volatile LAS unsigned* xbw = (volatile LAS unsigned*)(lds + LDS_BYTES - 16);
    if (threadIdx.x == 0) { xbw[0] = 0u; xbw[1] = 0u; xbw[2] = 0u; xbw[3] = 0u; }
    __syncthreads();
    XcdBarrier bar = xcd_barrier_post(p.bar, xbw);

#if PHMASK & (1 << 0)
    DUP(0) {
    {
        PHASE_IDS
        LAS float* scr = (LAS float*)lds;
        transpose_w<1>(p.w_gu1, D, 2 * F, p.Wgu1t, 2 * F, scr, tid, (int)blockIdx.x, (int)gridDim.x);
        transpose_w<0>(p.w_dn1, F, D, p.Wdn1t, D, scr, tid, (int)blockIdx.x, (int)gridDim.x);
        for (size_t e = gtid; e < (size_t)1024 * 64; e += gthreads) { const size_t ch = e >> 6, k = e & 63; p.Lw2t[e] = (bf16)(cvt_pk_bf16(p.w2[k * 1024 + ch], 0.f) & 0xffffu); p.La2t[e] = (bf16)(cvt_pk_bf16(p.a2[k * 1024 + ch], 0.f) & 0xffffu); }
        for (size_t e = gtid; e < (size_t)1024 * 160; e += gthreads) { const size_t ch = e / 160, k = e % 160; p.Lg2t[e] = (bf16)(cvt_pk_bf16(p.g2[k * 1024 + ch], 0.f) & 0xffffu); }
        for (size_t i = gtid; i < (size_t)MP * D / 8; i += gthreads) {
            const size_t row = i >> 8, c = (i & 255) * 8;
            u32x4 w = {0u, 0u, 0u, 0u};
            if (row < MT) { const float* s = (row < SEQ ? p.x_p + row * D : p.x_s + (row - SEQ) * D) + c; const float4 a = *(const float4*)s, b = *(const float4*)(s + 4);
                w.x = cvt_pk_bf16(a.x, a.y); w.y = cvt_pk_bf16(a.z, a.w); w.z = cvt_pk_bf16(b.x, b.y); w.w = cvt_pk_bf16(b.z, b.w); }
            *(u32x4*)(p.XAb + row * D + c) = w;
        }
        { const u32x4 z = {0u, 0u, 0u, 0u};
          for (size_t i = gtid; i < (size_t)128 * D / 8; i += gthreads) { *(u32x4*)(p.H1b + (size_t)MT * D + i * 8) = z; *(u32x4*)(p.H2b + (size_t)MT * D + i * 8) = z; }
          for (size_t i = gtid; i < (size_t)128 * 1024 / 8; i += gthreads) { *(u32x4*)(p.ROb + (size_t)MT * 1024 + i * 8) = z; *(u32x4*)(p.Ob + (size_t)MT * 1024 + i * 8) = z; } }
        for (size_t i = gtid; i < (size_t)NS * D / 4; i += gthreads) *(f32x4*)(p.PRE + (size_t)SEQ * D + i * 4) = *(const f32x4*)(p.x_s + i * 4) * ALPHA;
        { const u32x4 z = {0u, 0u, 0u, 0u};
          for (size_t i = gtid; i < (size_t)4 * 512 * 64 / 8; i += gthreads) { *(u32x4*)(p.KCb + i * 8) = z; *(u32x4*)(p.VCtb + i * 8) = z; } }
    }
    xcd_barrier(bar);
        }
#endif
#if PHMASK & (1 << 1)
    DUP(1) {
    { pg8::Gemm g{p.XAb, p.Wgu1t, MP, 2 * F, D}; pg8::StaticOrder S; S.init(MP, 2 * F, (int)gridDim.x, (int)blockIdx.x); EpiSwiglu E{p.ACTb};
      pg8::gemm_phase<EpiSwiglu, pg8::StaticOrder, true, true>(lds, g, S, E); }
    if (blockIdx.x >= 172) { PHASE_IDS __syncthreads(); transpose_w<2>(p.w_in, D, INC, p.Wint, NIN, (LAS float*)lds, tid, (int)blockIdx.x - 172, (int)gridDim.x - 172); }
    xcd_barrier(bar);
    }
    #endif
#if PHMASK & (1 << 2)
    DUP(2) {
    { pg8::Gemm g{p.ACTb, p.Wdn1t, SEQ, D, F}; PieceOrder S; S.init(SEQ, D, (int)gridDim.x, (int)blockIdx.x); S.npieces = 176; S.ppt = 22; S.pkt = 4; EpiResid E{p.PRE, p.x_p, p.x_s, 0.5f, p.SLAB, 22, nullptr, nullptr, nullptr};
      pg8::gemm_phase<EpiResid, PieceOrder, true, true>(lds, g, S, E); }
    xcd_barrier(bar);
    }
    #endif
#if PHMASK & (1 << 3)
    DUP(3) {
    { PHASE_IDS ln_rows<false>(p.PRE, p.ln1_g, p.ln1_b, p.LNST, p.H1b, p.o_y_p, p.o_y_s, p.SLAB, 22, gw, nw, lane, wid, (LAS float*)lds); }
    xcd_barrier(bar);
    }
    #endif
#if PHMASK & (1 << 4)
    DUP(4) {
    { pg8::Gemm g{p.H1b, p.Wint, MP, NIN, D}; pg8::StaticOrder S; S.init(MP, NIN, (int)gridDim.x, (int)blockIdx.x);
      EpiWin E{p.UA, p.Qb, p.Kc, p.Vc, p.GMb, p.o_cmp_p, p.o_sel_p, p.o_win_p, p.o_shift_p, p.o_cmp_s, p.o_sel_s, p.o_win_s, p.o_shift_s};
      pg8::gemm_phase<EpiWin, pg8::StaticOrder, true, true>(lds, g, S, E); }
    if (blockIdx.x >= 40) { PHASE_IDS __syncthreads(); const int wg = (int)blockIdx.x - 40, nwg = (int)gridDim.x - 40; LAS float* scr = (LAS float*)lds;
        transpose_w<0>(p.w_up_a, 1024, D, p.Wupat, D, scr, tid, wg, nwg); transpose_w<0>(p.w_up_b, 1024, D, p.Wupbt, D, scr, tid, wg, nwg); transpose_w<0>(p.w_o, D, D, p.Wot, D, scr, tid, wg, nwg);
        transpose_w<1>(p.w_gu2, D, 2 * F, p.Wgu2t, F, scr, tid, wg, nwg); }
    xcd_barrier(bar);
    }
    #endif
#if PHMASK & (1 << 5)
    DUP(5) {
#ifndef DUP_PREP
#define DUP_PREP 1
#endif
#ifndef DUP_SNSA
#define DUP_SNSA 1
#endif
#ifndef DUP_CV
#define DUP_CV 1
#endif
    { PHASE_IDS for (int r2 = 0; r2 < DUP_PREP; ++r2) rwkv_prep_phase(p, lds, tid);
      if (blockIdx.x >= 224) compress_phase<false>(p, lds, tid, (int)blockIdx.x - 224, 32);
      else if (blockIdx.x >= 64) vtrans_phase(p, (LAS bf16*)lds, tid, (int)blockIdx.x - 64, 160);
    }
    xcd_barrier(bar);
    }
    #endif
#if PHMASK & (1 << 6)
    DUP(6) {
    { PHASE_IDS
#ifndef DUP_SCAN
#define DUP_SCAN 1
#endif
#ifndef DUP_NSA
#define DUP_NSA 1
#endif
#ifndef SCAN_ALONE
#define SCAN_ALONE 0
#endif
    volatile LAS unsigned* scan_done = (volatile LAS unsigned*)(lds + LDS_BYTES - 32);
    if (tid == 0) *scan_done = 0u;
    __syncthreads();
    if (blockIdx.x < 64 && wid < 4) { __builtin_amdgcn_s_setprio(3); for (int r2 = 0; r2 < DUP_SCAN; ++r2) rwkv_scan_fast<false>(p, blockIdx.x * 4 + wid, lane, (LAS float*)(lds + 32768) + wid * 2560); __builtin_amdgcn_s_setprio(0);
        if (lane == 0) (void)__hip_atomic_fetch_add((LAS unsigned*)(lds + LDS_BYTES - 32), 1u, __ATOMIC_RELAXED, __HIP_MEMORY_SCOPE_WORKGROUP); }
    else { const int nsw = blockIdx.x < 64 ? blockIdx.x * 4 + (wid - 4) : 256 + (blockIdx.x - 64) * 8 + wid, nns = 256 + ((int)gridDim.x - 64) * 8;
           for (int it = nsw; it < 32 * 256; it += nns) rwkv_scan_fast<true>(p, it, lane, (LAS float*)(lds + 32768) + wid * 2560);
           if (blockIdx.x < 64) {
               for (size_t i = (size_t)(blockIdx.x * 4 + (wid - 4)) * 64 + lane; i < (size_t)32 * 508 * 128; i += (size_t)256 * 64) {
                   const size_t b = i / (508 * 128), rem = i % (508 * 128);
                   *(float4*)(p.o_win_s + b * 512 * 512 + rem * 4) = *(const float4*)(p.state_win + b * 512 * 512 + 4 * 512 + rem * 4);
               }
               while (*scan_done < 4u) __builtin_amdgcn_s_sleep(32); } }
    { LAS float* impL = (LAS float*)(lds + wid * 3072); LAS int* selL = (LAS int*)(lds + wid * 3072 + 2048); LAS int* stepL = (LAS int*)(lds + wid * 3072 + 2304);
      for (int r2 = 0; r2 < DUP_NSA; ++r2) {
          const int kv0 = (int)(xb_xcc_id() & 3u);
          for (int kk = 0; kk < 4 && !(SCAN_ALONE && blockIdx.x < 64 && wid >= 4); ++kk) {
              const int kvq = (kv0 + kk) & 3;
              for (;;) {
                  int idx = 0;
                  if (lane == 0) idx = (int)__hip_atomic_fetch_add(p.ctl + 16 * (rep_ + 2 * r2) + kvq, 1u, __ATOMIC_RELAXED, __HIP_MEMORY_SCOPE_AGENT);
                  idx = __builtin_amdgcn_readfirstlane(idx);
                  if (idx >= 2048) break;
                  nsa_prompt_item(p, (idx << 2) | kvq, lane, impL, selL, stepL);
              }
          }
      } }
    if (blockIdx.x >= 64) {
        __syncthreads();
        const int wg = (int)blockIdx.x - 64, nwg = (int)gridDim.x - 64;
        LAS float* scr = (LAS float*)lds;
        compress_phase<true>(p, lds, tid, wg, nwg);
        asm volatile("s_waitcnt vmcnt(0)" ::: "memory");
        __syncthreads();
        if (tid == 0) {
            __builtin_amdgcn_fence(__ATOMIC_RELEASE, "agent");
            asm volatile("s_waitcnt vmcnt(0)" ::: "memory");
            (void)__hip_atomic_fetch_add(p.ctl + 60, 1u, __ATOMIC_RELAXED, __HIP_MEMORY_SCOPE_AGENT);
            unsigned spins = 0;
            while (__hip_atomic_load(p.ctl + 60, __ATOMIC_RELAXED, __HIP_MEMORY_SCOPE_AGENT) < (unsigned)nwg && ++spins < (1u << 22)) __builtin_amdgcn_s_sleep(2);
            __builtin_amdgcn_fence(__ATOMIC_ACQUIRE, "agent");
            asm volatile("s_waitcnt vmcnt(0)" ::: "memory");
        }
        __syncthreads();
        for (int r2 = 0; r2 < DUP_SNSA; ++r2) nsa_sample_phase(p, lds, tid, wg, nwg);
    } }
    xcd_barrier(bar);
    }
#endif
#if PHMASK & (1 << 7)
    DUP(7) {
#ifdef NSA_CHECK
    { PHASE_IDS nsa_phase<false>(p, lds, tid); }
    xcd_barrier(bar);
    { PHASE_IDS float num = 0.f, den = 0.f;
      for (size_t i = gtid; i < (size_t)SEQ * 1024; i += gthreads) { const float a = bf_at(p.Ob + i), b = p.Ob2[i], d = a - b; num += d * d; den += b * b; }
      num = wave_sum(num); den = wave_sum(den);
      if (lane == 0) { atomicAdd((float*)(p.ctl + 16), num); atomicAdd((float*)(p.ctl + 17), den); } }
    xcd_barrier(bar);
#endif
    { PHASE_IDS rwkv_post_phase(p, tid); }
    xcd_barrier(bar);
    }
#endif
#if PHMASK & (1 << 8)
    DUP(8) {
    { pg8::Gemm g{p.ROb, p.Wupat, SEQ, D, 1024}; PieceOrder S; S.init(SEQ, D, (int)gridDim.x, (int)blockIdx.x); S.npieces = 32; S.ppt = 4; S.pkt = 4; EpiUp<false> E{p.MIXA, p.MIXb, p.GMb, p.SLAB, 0};
      pg8::gemm_phase<EpiUp<false>, PieceOrder, true, true>(lds, g, S, E); }
    { pg8::Gemm g{p.Ob, p.Wupbt, SEQ, D, 1024}; PieceOrder S; S.init(SEQ, D, (int)gridDim.x, (int)blockIdx.x); S.npieces = 32; S.ppt = 4; S.pkt = 4; EpiUp<true> E{p.MIXA, p.MIXb, p.GMb + D, p.SLAB, 1};
      pg8::gemm_phase<EpiUp<true>, PieceOrder, true, true>(lds, g, S, E); }
    if (blockIdx.x < 32) {
        asm volatile("s_waitcnt vmcnt(0)" ::: "memory");
        __syncthreads();
        if (threadIdx.x == 0) { __builtin_amdgcn_fence(__ATOMIC_RELEASE, "agent"); asm volatile("s_waitcnt vmcnt(0)" ::: "memory"); (void)__hip_atomic_fetch_add(p.ctl + 59, 1u, __ATOMIC_RELAXED, __HIP_MEMORY_SCOPE_AGENT); }
    } else if (blockIdx.x < 64) {
        if (threadIdx.x == 0) { unsigned spins = 0;
            while (__hip_atomic_load(p.ctl + 59, __ATOMIC_RELAXED, __HIP_MEMORY_SCOPE_AGENT) < 32u * (1u + (unsigned)rep_) && ++spins < (1u << 22)) __builtin_amdgcn_s_sleep(2);
            __builtin_amdgcn_fence(__ATOMIC_ACQUIRE, "agent"); asm volatile("s_waitcnt vmcnt(0)" ::: "memory"); }
        __syncthreads();
        for (int q = ((int)blockIdx.x - 32) * NTHR + (int)threadIdx.x; q < 128 * 256; q += 32 * NTHR) {
            const int sr = q >> 8, c8 = (q & 255) * 8, tile = c8 >> 8, cin = c8 & 255;
            f32x4 a0 = {0.f, 0.f, 0.f, 0.f}, a1 = a0;
#pragma unroll
            for (int k8 = 0; k8 < 8; ++k8) { const float* sl = p.SLAB + ((size_t)(((k8 >> 2) * 8 + tile) * 4 + (k8 & 3)) * 128 + sr) * 256 + cin; a0 += *(const f32x4*)sl; a1 += *(const f32x4*)(sl + 4); }
            u32x4 w; w.x = cvt_pk_bf16(a0[0], a0[1]); w.y = cvt_pk_bf16(a0[2], a0[3]); w.z = cvt_pk_bf16(a1[0], a1[1]); w.w = cvt_pk_bf16(a1[2], a1[3]);
            *(u32x4*)(p.MIXb + (size_t)(SEQ + sr) * D + c8) = w;
        }
    } else { PHASE_IDS __syncthreads(); transpose_w<3>(p.w_gu2, D, 2 * F, p.Wgu2t + (size_t)F * D, F, (LAS float*)lds, tid, (int)blockIdx.x - 64, (int)gridDim.x - 64); }
    xcd_barrier(bar);
    }
    #endif
#if PHMASK & (1 << 9)
    DUP(9) {
    { pg8::Gemm g{p.MIXb, p.Wot, SEQ, D, D}; PieceOrder S; S.init(SEQ, D, (int)gridDim.x, (int)blockIdx.x); S.npieces = 64; S.ppt = 8; S.pkt = 4; EpiResid E{p.PRE, p.PRE, p.PRE, 1.0f, p.SLAB, 8, p.LNST, p.ln1_g, p.ln1_b};
      pg8::gemm_phase<EpiResid, PieceOrder, true, true>(lds, g, S, E); }
    xcd_barrier(bar);
    }
    #endif
#if PHMASK & (1 << 10)
    DUP(10) {
    { PHASE_IDS ln_rows<false>(p.PRE, p.ln2_g, p.ln2_b, p.LNST, p.H2b, p.o_y_p, p.o_y_s, p.SLAB, 8, gw, nw, lane, wid, (LAS float*)lds); }
    xcd_barrier(bar);
    }
    #endif
#if PHMASK & (1 << 11)
    DUP(11) {
    { pg8::Gemm g{p.H2b, p.Wgu2t, MP, 2 * F, D}; pg8::StaticOrder S; S.init(MP, 2 * F, (int)gridDim.x, (int)blockIdx.x); EpiSwiglu E{p.ACTb};
      pg8::gemm_phase<EpiSwiglu, pg8::StaticOrder, true, true>(lds, g, S, E); }
    if (blockIdx.x >= 172) { PHASE_IDS __syncthreads(); transpose_w<0>(p.w_dn2, F, D, p.Wdn2t, D, (LAS float*)lds, tid, (int)blockIdx.x - 172, (int)gridDim.x - 172); }
    xcd_barrier(bar);
    }
    #endif
#if PHMASK & (1 << 12)
    DUP(12) {
    { pg8::Gemm g{p.ACTb, p.Wdn2t, SEQ, D, F}; PieceOrder S; S.init(SEQ, D, (int)gridDim.x, (int)blockIdx.x); S.npieces = 176; S.ppt = 22; S.pkt = 4; EpiResid E{p.PRE, p.PRE, p.PRE, 0.5f, p.SLAB, 22, p.LNST, p.ln2_g, p.ln2_b};
      pg8::gemm_phase<EpiResid, PieceOrder, true, true>(lds, g, S, E); }
    xcd_barrier(bar);
    }
    #endif
#if PHMASK & (1 << 13)
    DUP(13) {
    { PHASE_IDS ln_rows<true>(p.PRE, p.ln3_g, p.ln3_b, p.LNST, p.H2b, p.o_y_p, p.o_y_s, p.SLAB, 22, gw, nw, lane, wid, (LAS float*)lds); }
#ifdef NSA_CHECK
    { const float num = __hip_atomic_load((float*)(p.ctl + 16), __ATOMIC_RELAXED, __HIP_MEMORY_SCOPE_AGENT), den = __hip_atomic_load((float*)(p.ctl + 17), __ATOMIC_RELAXED, __HIP_MEMORY_SCOPE_AGENT);
      if (!(num <= NSA_CHECK_THR * den) && blockIdx.x == 0 && threadIdx.x == 0) p.o_y_s[0] = __builtin_nanf(""); }
#endif
    }
#endif
}
}

extern "C" void kernel_launch(void* const* d_in, const int* in_sizes, int n_in, void* d_out, int out_size, void* d_ws, size_t ws_size, hipStream_t stream) {
    static int grid = 0;
    if (grid == 0) {
        int dev = 0, cus = 0;
        if (hipGetDevice(&dev) != hipSuccess || hipDeviceGetAttribute(&cus, hipDeviceAttributeMultiprocessorCount, dev) != hipSuccess) { fprintf(stderr, "kernel_launch: device query failed\n"); grid = -1; return; }
        if (hipFuncSetAttribute((const void*)mega_fwd, hipFuncAttributeMaxDynamicSharedMemorySize, LDS_BYTES) != hipSuccess) { fprintf(stderr, "kernel_launch: hipFuncSetAttribute failed\n"); grid = -1; return; }
        int per_cu = 0;
        if (hipOccupancyMaxActiveBlocksPerMultiprocessor(&per_cu, (const void*)mega_fwd, NTHR, LDS_BYTES) != hipSuccess || per_cu < 1) { fprintf(stderr, "kernel_launch: occupancy query says %d blocks per CU\n", per_cu); }
        (void)hipGetLastError();
        grid = cus;
    }
    if (grid < 0) return;
    Params p{};
    const float* const* in = (const float* const*)d_in;
    p.x_p = in[0]; p.x_s = in[1]; p.cache_cmp = in[2]; p.cache_sel = in[3]; p.pt = (const int*)d_in[4]; p.state_win = in[5]; p.state_rwkv = in[6]; p.state_shift = in[7];
    p.ln1_g = in[8]; p.ln1_b = in[9]; p.w_gu1 = in[10]; p.w_dn1 = in[11]; p.w_in = in[12]; p.mu = in[13]; p.w0 = in[14]; p.w2 = in[15]; p.a0 = in[16]; p.a2 = in[17]; p.g2 = in[18];
    p.k_k = in[19]; p.k_a = in[20]; p.r_k = in[21]; p.rln_w = in[22]; p.rln_b = in[23]; p.w_up_a = in[24]; p.cmp_pe = in[25]; p.cmp_wa = in[26]; p.cmp_wb = in[27]; p.w_up_b = in[28]; p.w_o = in[29];
    p.ln2_g = in[30]; p.ln2_b = in[31]; p.w_gu2 = in[32]; p.w_dn2 = in[33]; p.ln3_g = in[34]; p.ln3_b = in[35];
    float* out = (float*)d_out; size_t off = 0;
    p.o_y_p = out + off; off += (size_t)SEQ * D;
    p.o_y_s = out + off; off += (size_t)NS * D;
    p.o_cmp_p = out + off; off += (size_t)SEQ * 512;
    p.o_sel_p = out + off; off += (size_t)SEQ * 512;
    p.o_win_p = out + off; off += (size_t)512 * 512;
    p.o_state_p = out + off; off += (size_t)16 * 4096;
    p.o_shift_p = out + off; off += RCOLS;
    p.o_cmp_s = out + off; off += (size_t)NS * 512;
    p.o_sel_s = out + off; off += (size_t)NS * 512;
    p.o_win_s = out + off; off += (size_t)32 * 512 * 512;
    p.o_state_s = out + off; off += (size_t)32 * 16 * 4096;
    p.o_shift_s = out + off; off += (size_t)32 * RCOLS;

    unsigned char* ws = (unsigned char*)d_ws; size_t w = 0;
    auto alloc = [&](size_t bytes) { unsigned char* q = ws + w; w += (bytes + 255) & ~(size_t)255; return q; };
    p.bar = (unsigned*)alloc((XCD_BAR_WORDS + 64) * sizeof(unsigned)); p.ctl = p.bar + XCD_BAR_WORDS;
    p.XAb = (bf16*)alloc((size_t)MP * D * 2); p.ACTb = (bf16*)alloc((size_t)MP * F * 2); p.H1b = (bf16*)alloc((size_t)MP * D * 2); p.H2b = (bf16*)alloc((size_t)MP * D * 2);
    p.Qb = (bf16*)alloc((size_t)MP * 1024 * 2); p.Kc = (bf16*)alloc((size_t)12 * MP * 64 * 2); p.Vc = (bf16*)alloc((size_t)12 * MP * 64 * 2); p.GMb = (bf16*)alloc((size_t)MP * 4096 * 2);
    p.Vtb = (bf16*)alloc((size_t)8 * 128 * 4096 * 2 + 8192); p.KCb = (bf16*)alloc((size_t)4 * 512 * 64 * 2); p.VCtb = (bf16*)alloc((size_t)4 * 512 * 64 * 2);
    p.ROb = (bf16*)alloc((size_t)MP * 1024 * 2); p.Ob = (bf16*)alloc((size_t)MP * 1024 * 2); p.MIXb = (bf16*)alloc((size_t)MP * D * 2);
    p.Wgu1t = (bf16*)alloc((size_t)2 * F * D * 2); p.Wdn1t = (bf16*)alloc((size_t)D * F * 2); p.Wint = (bf16*)alloc((size_t)NIN * D * 2);
    p.Wupat = (bf16*)alloc((size_t)D * 1024 * 2); p.Wupbt = (bf16*)alloc((size_t)D * 1024 * 2); p.Wot = (bf16*)alloc((size_t)D * D * 2);
    p.Wgu2t = (bf16*)alloc((size_t)2 * F * D * 2); p.Wdn2t = (bf16*)alloc((size_t)D * F * 2);
    p.Lw2t = (bf16*)alloc((size_t)1024 * 64 * 2); p.La2t = (bf16*)alloc((size_t)1024 * 64 * 2); p.Lg2t = (bf16*)alloc((size_t)1024 * 160 * 2);
    p.PRE = (float*)alloc((size_t)MP * D * 4); p.LNST = (float*)alloc((size_t)MP * 2 * 4);
    p.UA = (float*)alloc((size_t)MP * UAW * 4); p.MIXA = (float*)alloc((size_t)MP * D * 4); p.SLAB = (float*)alloc((size_t)8 * 22 * 128 * 256 * 4);
    p.SC = (float*)alloc((size_t)MT * SCR * 4); p.YS = (float*)alloc((size_t)MT * 2048 * 4); p.C12 = (float*)alloc((size_t)MT * 64 * 4); p.G = (float*)alloc((size_t)MT * 1024 * 4);
    p.KCVs = (float*)alloc((size_t)32 * 511 * 512 * 4);
#ifdef NSA_CHECK
    p.KCVp = (float*)alloc((size_t)511 * 512 * 4); p.Ob2 = (float*)alloc((size_t)SEQ * 1024 * 4);
#endif
    if (w > ws_size) { fprintf(stderr, "kernel_launch: workspace too small: need %zu, have %zu\n", w, ws_size); return; }
    if (hipMemsetAsync(p.bar, 0, (XCD_BAR_WORDS + 64) * sizeof(unsigned), stream) != hipSuccess) { fprintf(stderr, "kernel_launch: memset failed\n"); return; }
    hipLaunchKernelGGL(mega_fwd, dim3(grid), dim3(NTHR), LDS_BYTES, stream, p);
    const hipError_t le = hipPeekAtLastError();
    if (le != hipSuccess) fprintf(stderr, "kernel_launch: launch failed: %s\n", hipGetErrorName(le));
}
```
